# Optimizing an MI355X kernel written in HIP

```python
import numpy as np
import jax, jax.numpy as jnp
from jax import lax

D_MODEL = 1024
BATCH = 8
SEQ = 4096
DEPTH = 4

N_MIXERS = 4
ALPHA = (2.0 * DEPTH) ** 0.25
BETA = (8.0 * DEPTH) ** -0.25
LN_EPS = 1e-5
NEG_INF = -1e30
TINY = 1e-30
ROPE_THETA = 10000.0

MLSTM_HEADS = 8
MLSTM_QK_DIM = D_MODEL // MLSTM_HEADS // 2
MLSTM_V_DIM = D_MODEL // MLSTM_HEADS
MLSTM_CONV = 4
MLSTM_CHUNK = 64

NSA_HEADS = 16
NSA_KV_HEADS = 4
NSA_HEAD_DIM = D_MODEL // NSA_HEADS
CMP_STRIDE = 16
CMP_BLK = 2 * CMP_STRIDE
SEL_BLK = 64
N_SEL = 16
NSA_WINDOW = 512
NSA_QB = 32
FORCE_SCORE = 1e4

DIL_HEADS = 16
DIL_HEAD_DIM = D_MODEL // DIL_HEADS
DIL_GROUPS = ((128, 1), (512, 4), (2048, 16))

POOL_WINDOWS = (2, 4, 8, 16)
POOL_GROUP = D_MODEL // len(POOL_WINDOWS)

N_EXPERTS = 64
TOP_K = 8
N_EXPERT_GROUPS = 8
TOPK_GROUPS = 4
EXPERT_FF = 256
SHARED_FF = 256
ROUTED_SCALE = 2.5
ROW_BLK = 128

PLE_DIM = 256

kernel_name = "hybrid_mlstm_nsa_dilated_pool_moe"


def _n_uses(m):
    return (DEPTH - m + N_MIXERS - 1) // N_MIXERS


def split_cols(t, sizes):
    return jnp.split(t, np.cumsum(sizes)[:-1].tolist(), axis=-1)


def layer_norm(x, g, b):
    xf = x.astype(jnp.float32)
    mu = xf.mean(-1, keepdims=True)
    var = jnp.square(xf - mu).mean(-1, keepdims=True)
    return ((xf - mu) * lax.rsqrt(var + LN_EPS) * g + b).astype(x.dtype)


def rope(t, pos):
    half = t.shape[-1] // 2
    inv = ROPE_THETA ** (-jnp.arange(half, dtype=jnp.float32) / half)
    ang = pos.astype(jnp.float32)[:, None] * inv[None, :]
    cos, sin = jnp.cos(ang)[:, None, :], jnp.sin(ang)[:, None, :]
    tf = t.astype(jnp.float32)
    t1, t2 = tf[..., :half], tf[..., half:]
    return jnp.concatenate([t1 * cos - t2 * sin, t1 * sin + t2 * cos], -1).astype(t.dtype)


def masked_softmax(s, mask):
    s = jnp.where(mask, s, NEG_INF)
    m = s.max(-1, keepdims=True)
    e = jnp.where(mask, jnp.exp(s - m), 0.0)
    return e / jnp.maximum(e.sum(-1, keepdims=True), TINY)


def swiglu(t, wg, wu, wd):
    return (jax.nn.silu(t @ wg) * (t @ wu)) @ wd


def causal_dwconv(x, w):
    return lax.conv_general_dilated(x, w[:, None, :], window_strides=(1,),
                                    padding=[(w.shape[0] - 1, 0)],
                                    dimension_numbers=('NWC', 'WIO', 'NWC'),
                                    feature_group_count=x.shape[-1])


def mlstm_chunk_step(carry, inp):
    C, n, m = carry
    q, k, v, ig, lf = inp
    L = q.shape[2]
    tri = jnp.arange(L)[:, None] >= jnp.arange(L)[None, :]
    b = jnp.cumsum(lf, axis=-1)
    logD = jnp.where(tri, b[..., :, None] - b[..., None, :] + ig[..., None, :], NEG_INF)
    inter = b + m[..., None]
    m_t = jnp.maximum(inter, logD.max(-1))
    s = jnp.einsum('bhtd,bhsd->bhts', q, k) * jnp.exp(logD - m_t[..., None])
    w_inter = jnp.exp(inter - m_t)
    num = w_inter[..., None] * jnp.einsum('bhtd,bhdv->bhtv', q, C) + jnp.einsum('bhts,bhsv->bhtv', s, v)
    den = w_inter * jnp.einsum('bhtd,bhd->bht', q, n) + s.sum(-1)
    h = num / jnp.maximum(jnp.abs(den), jnp.exp(-m_t))[..., None]
    bL = b[..., -1]
    logw = bL[..., None] - b + ig
    m_new = jnp.maximum(bL + m, logw.max(-1))
    w = jnp.exp(logw - m_new[..., None])
    decay = jnp.exp(bL + m - m_new)
    C_new = decay[..., None, None] * C + jnp.einsum('bhs,bhsd,bhsv->bhdv', w, k, v)
    n_new = decay[..., None] * n + jnp.einsum('bhs,bhsd->bhd', w, k)
    return (C_new, n_new, m_new), h


def mlstm_mixer(x, w_in, conv_w, ig_bias, fg_bias, norm_g, w_out):
    B, S, _ = x.shape
    H, dk, dv, L = MLSTM_HEADS, MLSTM_QK_DIM, MLSTM_V_DIM, MLSTM_CHUNK
    qk, v, o, ig, fg = split_cols(x @ w_in, [2 * H * dk, H * dv, H * dv, H, H])
    q, k = jnp.split(jax.nn.silu(causal_dwconv(qk, conv_w)), 2, axis=-1)
    f32 = jnp.float32
    q = q.reshape(B, S, H, dk).astype(f32) * dk ** -0.5
    k = k.reshape(B, S, H, dk).astype(f32)
    v = v.reshape(B, S, H, dv).astype(f32)
    ig = ig.astype(f32) + ig_bias.astype(f32)
    lf = jax.nn.log_sigmoid(fg.astype(f32) + fg_bias.astype(f32))
    nc = S // L
    c4 = lambda t: t.reshape(B, nc, L, H, t.shape[-1]).transpose(1, 0, 3, 2, 4)
    c3 = lambda t: t.reshape(B, nc, L, H).transpose(1, 0, 3, 2)
    init = (jnp.zeros((B, H, dk, dv), f32), jnp.zeros((B, H, dk), f32), jnp.zeros((B, H), f32))
    _, h = lax.scan(mlstm_chunk_step, init, (c4(q), c4(k), c4(v), c3(ig), c3(lf)))
    h = h.transpose(1, 0, 3, 2, 4).reshape(B, S, H, dv)
    mu = h.mean(-1, keepdims=True)
    hn = (h - mu) * lax.rsqrt(jnp.square(h - mu).mean(-1, keepdims=True) + LN_EPS)
    hn = hn.reshape(B, S, H * dv) * norm_g
    out = hn * jax.nn.sigmoid(o.astype(f32))
    return out.astype(x.dtype) @ w_out


def nsa_mixer(x, w_in, cmp_pos_k, cmp_pos_v, cmp_wk, cmp_wv, w_out):
    B, S, _ = x.shape
    H, G, dh = NSA_HEADS, NSA_KV_HEADS, NSA_HEAD_DIM
    J = H // G
    kv = G * dh
    q, kc, vc, ks, vs, kw, vw, g = split_cols(x @ w_in, [H * dh] + [kv] * 6 + [3 * H])
    pos = jnp.arange(S)
    q = rope(q.reshape(B, S, H, dh), pos)

    def compress(t, pos_emb, w):
        ch = t.reshape(B, S // CMP_STRIDE, CMP_STRIDE, G, dh)
        blocks = jnp.concatenate([ch[:, :-1], ch[:, 1:]], axis=2)
        return jnp.einsum('bclgd,lde->bcge', blocks + pos_emb[None, None, :, None, :], w)

    n_cmp = S // CMP_STRIDE - 1
    cmp_end = jnp.arange(n_cmp) * CMP_STRIDE + CMP_BLK - 1
    kc = rope(compress(kc.reshape(B, S, G, dh), cmp_pos_k, cmp_wk), cmp_end)
    vc = compress(vc.reshape(B, S, G, dh), cmp_pos_v, cmp_wv)
    n_sblk = S // SEL_BLK
    n_sel = min(N_SEL, n_sblk)
    ks_blk = rope(ks.reshape(B, S, G, dh), pos).reshape(B, n_sblk, SEL_BLK, G, dh).transpose(0, 3, 1, 2, 4)
    vs_blk = vs.reshape(B, n_sblk, SEL_BLK, G, dh).transpose(0, 3, 1, 2, 4)
    padw = ((0, 0), (NSA_WINDOW, 0), (0, 0), (0, 0))
    kw_pad = jnp.pad(rope(kw.reshape(B, S, G, dh), pos), padw)
    vw_pad = jnp.pad(vw.reshape(B, S, G, dh), padw)
    c_idx, s_idx = jnp.arange(n_cmp), jnp.arange(n_sblk)
    overlap = ((c_idx[:, None] * CMP_STRIDE + CMP_BLK - 1 >= s_idx[None, :] * SEL_BLK)
               & (c_idx[:, None] * CMP_STRIDE < (s_idx[None, :] + 1) * SEL_BLK)).astype(jnp.float32)
    n_qb = S // NSA_QB
    qb = q.reshape(B, n_qb, NSA_QB, G, J, dh).transpose(1, 0, 3, 4, 2, 5)
    gb = jax.nn.sigmoid(g.astype(jnp.float32)).reshape(B, n_qb, NSA_QB, G, J, 3).transpose(1, 0, 3, 4, 2, 5)
    q0s = jnp.arange(n_qb, dtype=jnp.int32) * NSA_QB
    scale = dh ** -0.5
    bi = jnp.arange(B)[:, None, None, None]
    gi = jnp.arange(G)[None, :, None, None]

    def block(args):
        qi, gate, q0 = args
        t = q0 + jnp.arange(NSA_QB)
        s = jnp.einsum('bgjqd,bcgd->bgjqc', qi, kc).astype(jnp.float32) * scale
        p_cmp = masked_softmax(s, cmp_end[None, :] <= t[:, None])
        o_cmp = jnp.einsum('bgjqc,bcgd->bgjqd', p_cmp, vc)
        imp = jnp.einsum('bgjqc,cn->bgqn', p_cmp, overlap)
        qblk = t // SEL_BLK
        forced = (s_idx[None, :] == 0) | (s_idx[None, :] == qblk[:, None]) | (s_idx[None, :] == qblk[:, None] - 1)
        imp = jnp.where(forced, FORCE_SCORE, jnp.where(s_idx[None, :] > qblk[:, None], NEG_INF, imp))
        _, sel = lax.top_k(imp, n_sel)
        k_sel = ks_blk[bi, gi, sel]
        v_sel = vs_blk[bi, gi, sel].reshape(B, G, NSA_QB, n_sel * SEL_BLK, dh)
        s = jnp.einsum('bgjqd,bgqnkd->bgjqnk', qi, k_sel).astype(jnp.float32) * scale
        kpos = sel[..., None] * SEL_BLK + jnp.arange(SEL_BLK)
        valid = (kpos <= t[None, None, :, None, None]).reshape(B, G, 1, NSA_QB, n_sel * SEL_BLK)
        p_slc = masked_softmax(s.reshape(B, G, J, NSA_QB, n_sel * SEL_BLK), valid)
        o_slc = jnp.einsum('bgjqm,bgqmd->bgjqd', p_slc, v_sel)
        kwin = lax.dynamic_slice_in_dim(kw_pad, q0, NSA_WINDOW + NSA_QB, axis=1)
        vwin = lax.dynamic_slice_in_dim(vw_pad, q0, NSA_WINDOW + NSA_QB, axis=1)
        wpos = q0 - NSA_WINDOW + jnp.arange(NSA_WINDOW + NSA_QB)
        dist = t[:, None] - wpos[None, :]
        wvalid = (dist >= 0) & (dist < NSA_WINDOW) & (wpos[None, :] >= 0)
        s = jnp.einsum('bgjqd,bkgd->bgjqk', qi, kwin).astype(jnp.float32) * scale
        o_win = jnp.einsum('bgjqk,bkgd->bgjqd', masked_softmax(s, wvalid), vwin)
        return gate[..., 0:1] * o_cmp + gate[..., 1:2] * o_slc + gate[..., 2:3] * o_win

    o = lax.map(block, (qb, gb, q0s))
    o = o.transpose(1, 0, 4, 2, 3, 5).reshape(B, S, H * dh)
    return o.astype(x.dtype) @ w_out


def dilated_band_attn(q, k, v, window, dil):
    B, S, H, dh = q.shape
    steps = window // dil
    span = steps * dil
    sp = -(-S // span) * span
    nb = sp // span
    padw = ((0, 0), (0, sp - S), (0, 0), (0, 0))
    blocks = lambda t: jnp.pad(t, padw).reshape(B, nb, steps, dil, H, dh)
    band = lambda t: jnp.concatenate(
        [jnp.pad(t, ((0, 0), (1, 0), (0, 0), (0, 0), (0, 0), (0, 0)))[:, :-1], t], axis=2)
    qb = blocks(q)
    kband, vband = band(blocks(k)), band(blocks(v))
    s = jnp.einsum('bnqrhd,bnkrhd->bnrhqk', qb, kband).astype(jnp.float32) * dh ** -0.5
    qi, kj = jnp.arange(steps), jnp.arange(2 * steps)
    dist = steps + qi[:, None] - kj[None, :]
    valid = ((dist >= 0) & (dist <= steps))[None] & ~((jnp.arange(nb) == 0)[:, None, None] & (kj < steps)[None, None, :])
    s = jnp.where(valid[None, :, None, None], s, NEG_INF)
    m = s.max(-1, keepdims=True)
    e = jnp.exp(s - m)
    den = e.sum(-1, keepdims=True)
    o = jnp.einsum('bnrhqk,bnkrhd->bnqrhd', e / den, vband).reshape(B, sp, H, dh)[:, :S]
    lse = (m + jnp.log(den))[..., 0].transpose(0, 1, 4, 2, 3).reshape(B, sp, H)[:, :S]
    return o, lse


def dilated_mixer(x, w_in, w_out):
    B, S, _ = x.shape
    H, dh = DIL_HEADS, DIL_HEAD_DIM
    parts = split_cols(x @ w_in, [H * dh] * (2 * len(DIL_GROUPS) + 1))
    v = parts[-1].reshape(B, S, H, dh)
    pos = jnp.arange(S)
    outs, lses = [], []
    for gi_, (window, dil) in enumerate(DIL_GROUPS):
        q = rope(parts[2 * gi_].reshape(B, S, H, dh), pos)
        k = rope(parts[2 * gi_ + 1].reshape(B, S, H, dh), pos)
        o, lse = dilated_band_attn(q, k, v, window, dil)
        outs.append(o)
        lses.append(lse)
    wts = jax.nn.softmax(jnp.stack(lses, 0), axis=0)
    o = jnp.einsum('gbsh,gbshd->bshd', wts, jnp.stack(outs, 0))
    return o.reshape(B, S, H * dh).astype(x.dtype) @ w_out


def pool_mixer(x, w_grp, scale):
    B, S, _ = x.shape
    xf = x.astype(jnp.float32)
    cs = lax.cumsum(xf, axis=1)
    cnt = jnp.arange(1, S + 1, dtype=jnp.float32)[None, :, None]
    outs = []
    for g, w in enumerate(POOL_WINDOWS):
        sl = slice(g * POOL_GROUP, (g + 1) * POOL_GROUP)
        c = cs[..., sl]
        lagged = jnp.pad(c, ((0, 0), (w, 0), (0, 0)))[:, :S]
        mean = (c - lagged) / jnp.minimum(cnt, float(w))
        outs.append((mean - xf[..., sl]).astype(x.dtype) @ w_grp[g])
    return jnp.concatenate(outs, -1) * scale


def routed_experts(xf, eidx, gw, w_gate, w_up, w_down):
    T, D = xf.shape
    A = T * TOP_K
    flat_e = eidx.reshape(A)
    order = jnp.argsort(flat_e)
    sorted_e = flat_e[order]
    counts = jnp.bincount(flat_e, length=N_EXPERTS)
    padded = (counts + ROW_BLK - 1) // ROW_BLK * ROW_BLK
    pad_end = jnp.cumsum(padded)
    pad_start = pad_end - padded
    start = jnp.cumsum(counts) - counts
    dest = pad_start[sorted_e] + (jnp.arange(A) - start[sorted_e])
    n_blk = -(-A // ROW_BLK) + N_EXPERTS
    tok = order // TOP_K
    rows = jnp.zeros((n_blk * ROW_BLK, D), xf.dtype).at[dest].set(xf[tok])
    blk_expert = jnp.minimum(jnp.searchsorted(pad_end, jnp.arange(n_blk) * ROW_BLK, side='right'), N_EXPERTS - 1)

    def expert_block(args):
        xb, e = args
        return swiglu(xb, w_gate[e], w_up[e], w_down[e])

    out = lax.map(expert_block, (rows.reshape(n_blk, ROW_BLK, D), blk_expert)).reshape(-1, D)
    contrib = out[dest].astype(jnp.float32) * gw.reshape(A)[order][:, None]
    return jax.ops.segment_sum(contrib, tok, num_segments=T)


def moe_ffn(x, router_w, router_bias, w_gate, w_up, w_down, ws_gate, ws_up, ws_down):
    B, S, D = x.shape
    T = B * S
    xf = x.reshape(T, D)
    scores = jax.nn.sigmoid((xf @ router_w).astype(jnp.float32))
    biased = scores + router_bias.astype(jnp.float32)
    per = N_EXPERTS // N_EXPERT_GROUPS
    grp_score = lax.top_k(biased.reshape(T, N_EXPERT_GROUPS, per), 2)[0].sum(-1)
    _, gidx = lax.top_k(grp_score, TOPK_GROUPS)
    gmask = jax.nn.one_hot(gidx, N_EXPERT_GROUPS, dtype=jnp.float32).sum(1) > 0
    emask = jnp.repeat(gmask, per, axis=1)
    _, eidx = lax.top_k(jnp.where(emask, biased, NEG_INF), TOP_K)
    gw = jnp.take_along_axis(scores, eidx, axis=1)
    gw = gw / gw.sum(-1, keepdims=True) * ROUTED_SCALE
    routed = routed_experts(xf, eidx, gw, w_gate, w_up, w_down)
    shared = swiglu(xf, ws_gate, ws_up, ws_down).astype(jnp.float32)
    return (routed + shared).astype(x.dtype).reshape(B, S, D)


def setup_inputs(seed: int = 0) -> dict:
    key = jax.random.key(seed)
    kit = iter(list(jax.random.split(key, 40)))
    f32 = jnp.float32

    def nrm(shape, scale):
        return jax.random.normal(next(kit), shape, f32) * scale

    D = D_MODEL
    nA, nB, nC, nD = (_n_uses(m) for m in range(N_MIXERS))
    mH, dk, dv = MLSTM_HEADS, MLSTM_QK_DIM, MLSTM_V_DIM
    nH, nG, ndh = NSA_HEADS, NSA_KV_HEADS, NSA_HEAD_DIM
    dH, ddh = DIL_HEADS, DIL_HEAD_DIM
    mlstm_in = 2 * mH * dk + 2 * mH * dv + 2 * mH
    nsa_in = nH * ndh + 6 * nG * ndh + 3 * nH
    dil_in = (2 * len(DIL_GROUPS) + 1) * dH * ddh
    return {
        "x": nrm((BATCH, SEQ, D), 1.0),
        "p": nrm((DEPTH, BATCH, SEQ, PLE_DIM), 1.0),
        "ln_g": 1.0 + nrm((DEPTH, 2, D), 0.02),
        "ln_b": nrm((DEPTH, 2, D), 0.02),
        "mlstm_w_in": nrm((nA, D, mlstm_in), D ** -0.5),
        "mlstm_conv": nrm((nA, MLSTM_CONV, 2 * mH * dk), MLSTM_CONV ** -0.5),
        "mlstm_ig_bias": nrm((nA, mH), 0.1),
        "mlstm_fg_bias": jnp.linspace(3.0, 6.0, mH, dtype=f32)[None, :] + nrm((nA, mH), 0.1),
        "mlstm_norm_g": 1.0 + nrm((nA, mH * dv), 0.02),
        "mlstm_w_out": nrm((nA, mH * dv, D), BETA * (mH * dv) ** -0.5),
        "nsa_w_in": nrm((nB, D, nsa_in), D ** -0.5),
        "nsa_cmp_pos_k": nrm((nB, CMP_BLK, ndh), 0.02),
        "nsa_cmp_pos_v": nrm((nB, CMP_BLK, ndh), 0.02),
        "nsa_cmp_wk": nrm((nB, CMP_BLK, ndh, ndh), (CMP_BLK * ndh) ** -0.5),
        "nsa_cmp_wv": nrm((nB, CMP_BLK, ndh, ndh), (CMP_BLK * ndh) ** -0.5),
        "nsa_w_out": nrm((nB, nH * ndh, D), BETA * (nH * ndh) ** -0.5),
        "dil_w_in": nrm((nC, D, dil_in), D ** -0.5),
        "dil_w_out": nrm((nC, dH * ddh, D), BETA * (dH * ddh) ** -0.5),
        "pool_w": nrm((nD, len(POOL_WINDOWS), POOL_GROUP, POOL_GROUP), BETA * POOL_GROUP ** -0.5),
        "pool_scale": 1.0 + nrm((nD, D), 0.1),
        "router_w": nrm((DEPTH, D, N_EXPERTS), D ** -0.5),
        "router_bias": nrm((DEPTH, N_EXPERTS), 0.01),
        "exp_w_gate": nrm((DEPTH, N_EXPERTS, D, EXPERT_FF), D ** -0.5),
        "exp_w_up": nrm((DEPTH, N_EXPERTS, D, EXPERT_FF), D ** -0.5),
        "exp_w_down": nrm((DEPTH, N_EXPERTS, EXPERT_FF, D), BETA * EXPERT_FF ** -0.5),
        "sh_w_gate": nrm((DEPTH, D, SHARED_FF), D ** -0.5),
        "sh_w_up": nrm((DEPTH, D, SHARED_FF), D ** -0.5),
        "sh_w_down": nrm((DEPTH, SHARED_FF, D), BETA * SHARED_FF ** -0.5),
        "ple_w": nrm((DEPTH, PLE_DIM, D), BETA * PLE_DIM ** -0.5),
        "ple_gate_w": nrm((DEPTH, D, D), D ** -0.5),
    }


def reference(x, p, ln_g, ln_b, mlstm_w_in, mlstm_conv, mlstm_ig_bias, mlstm_fg_bias, mlstm_norm_g,
              mlstm_w_out, nsa_w_in, nsa_cmp_pos_k, nsa_cmp_pos_v, nsa_cmp_wk, nsa_cmp_wv, nsa_w_out,
              dil_w_in, dil_w_out, pool_w, pool_scale, router_w, router_bias, exp_w_gate, exp_w_up,
              exp_w_down, sh_w_gate, sh_w_up, sh_w_down, ple_w, ple_gate_w):
    for i in range(DEPTH):
        kind, j = i % N_MIXERS, i // N_MIXERS
        if kind == 0:
            y = mlstm_mixer(x, mlstm_w_in[j], mlstm_conv[j], mlstm_ig_bias[j], mlstm_fg_bias[j],
                            mlstm_norm_g[j], mlstm_w_out[j])
        elif kind == 1:
            y = nsa_mixer(x, nsa_w_in[j], nsa_cmp_pos_k[j], nsa_cmp_pos_v[j], nsa_cmp_wk[j],
                          nsa_cmp_wv[j], nsa_w_out[j])
        elif kind == 2:
            y = dilated_mixer(x, dil_w_in[j], dil_w_out[j])
        else:
            y = pool_mixer(x, pool_w[j], pool_scale[j])
        x = layer_norm(ALPHA * x + y, ln_g[i, 0], ln_b[i, 0])
        f = moe_ffn(x, router_w[i], router_bias[i], exp_w_gate[i], exp_w_up[i], exp_w_down[i],
                    sh_w_gate[i], sh_w_up[i], sh_w_down[i])
        x = layer_norm(ALPHA * x + f, ln_g[i, 1], ln_b[i, 1])
        x = x + (jax.nn.sigmoid(x @ ple_gate_w[i]) * (p[i] @ ple_w[i])).astype(x.dtype)
    return x
```

```cpp
#include <hip/hip_runtime.h>
#include <cstdio>
#include <cstdint>

#define LAS __attribute__((address_space(3)))
#define GAS __attribute__((address_space(1)))
typedef unsigned short bf16_t;
typedef short bf16x8 __attribute__((ext_vector_type(8)));
typedef short bf16x4 __attribute__((ext_vector_type(4)));
typedef float f32x4 __attribute__((ext_vector_type(4)));
typedef float f32x2 __attribute__((ext_vector_type(2)));
typedef unsigned u32x4 __attribute__((ext_vector_type(4)));
typedef unsigned u32x2 __attribute__((ext_vector_type(2)));

typedef __bf16 bf16v2_t __attribute__((ext_vector_type(2)));
__device__ __forceinline__ unsigned cvt_pk_bf16(float lo, float hi) { const f32x2 v = {lo, hi}; return __builtin_bit_cast(unsigned, __builtin_convertvector(v, bf16v2_t)); }
__device__ __forceinline__ unsigned pk4_fp8(float a, float b, float c, float d) {
    a = __builtin_fminf(__builtin_fmaxf(a, -448.f), 448.f); b = __builtin_fminf(__builtin_fmaxf(b, -448.f), 448.f);
    c = __builtin_fminf(__builtin_fmaxf(c, -448.f), 448.f); d = __builtin_fminf(__builtin_fmaxf(d, -448.f), 448.f);
    int w = 0; w = __builtin_amdgcn_cvt_pk_fp8_f32(a, b, w, false); w = __builtin_amdgcn_cvt_pk_fp8_f32(c, d, w, true); return (unsigned)w; }
__device__ __forceinline__ float bf2f(unsigned short b) { return __uint_as_float(((unsigned)b) << 16); }
__device__ __forceinline__ float bflo(unsigned w) { return __uint_as_float(w << 16); }
__device__ __forceinline__ float bfhi(unsigned w) { return __uint_as_float(w & 0xffff0000u); }
__device__ __forceinline__ float fast_exp2(float x) { return __builtin_amdgcn_exp2f(x); }
__device__ __forceinline__ float fast_rcp(float x) { return __builtin_amdgcn_rcpf(x); }
__device__ __forceinline__ float fexp(float x) { return fast_exp2(1.44269504f * x); }
__device__ __forceinline__ float flog(float x) { return __builtin_amdgcn_logf(x) * 0.69314718f; }
__device__ __forceinline__ float frsq(float x) { return __builtin_amdgcn_rsqf(x); }
__device__ __forceinline__ float sigmoidf_(float x) { return fast_rcp(1.0f + fast_exp2(-1.44269504f * x)); }

namespace pg8 {
constexpr int BM = 256, BK = 64, HALF = 128, HTB = HALF * BK * 2  , STAGE_BYTES = 8 * HTB, NXCD = 8, WGM = 8;
__host__ __device__ __forceinline__ int lds_byte(int r, int c) { const int st = (r >> 4) * 2 + (c >> 5), rr = r & 15, cc = c & 31, ob = rr * 64 + cc * 2; return st * 1024 + (ob ^ (((ob >> 9) & 1) << 5)); }
__host__ __device__ __forceinline__ void stage_rc(int b, int& R, int& C) { const int st = b / 1024, sb = b % 1024, swz = sb ^ (((sb >> 9) & 1) << 5); R = (st >> 1) * 16 + swz / 64; C = (st & 1) * 32 + (swz % 64) / 2; }
__host__ __device__ __forceinline__ int perm32(int rho) { const int n = rho >> 4, i = rho & 15; return 8 * (i >> 2) + 4 * n + (i & 3); }

struct Unit { int pm, pn, e; };
struct Gemm { const bf16_t* A; const bf16_t* Bt; int lda, ldb, K; };

struct SchedPlain {
    int nM, nN, nwg, G, c, lda, ldb, acs;
    __device__ void init(int M, int N, int G_, int c_, int lda_, int ldb_, int acs_) { nM = M / BM; nN = N / BM; nwg = nM * nN; G = G_; c = c_; lda = lda_; ldb = ldb_; acs = acs_; }
    __device__ __forceinline__ bool next(int i, Unit& u) const {
        const long L = (long)i * G + c; if (L >= nwg) return false;
        int wgid = (int)L; { const int q = nwg / NXCD, r = nwg % NXCD, xcd = wgid % NXCD, off = wgid / NXCD; wgid = (xcd < r ? xcd * (q + 1) : r * (q + 1) + (xcd - r) * q) + off; }
        const int nig = WGM * nN, gid = wgid / nig, fm = gid * WGM, gsz = (nM - fm) < WGM ? (nM - fm) : WGM;
        u.pm = fm + ((wgid % nig) % gsz); u.pn = (wgid % nig) / gsz; u.e = 0; return true;
    }
    __device__ __forceinline__ size_t aoff(const Unit& u) const { return ((size_t)u.pm * BM * lda + (size_t)u.pn * acs) * 2; }
    __device__ __forceinline__ size_t boff(const Unit& u) const { return (size_t)u.pn * BM * ldb * 2; }
    __device__ __forceinline__ const int* rows(const Unit&) const { return nullptr; }
};
struct SchedSimple {
    int nN, nwg, G, c, lda, ldb, acs;
    __device__ void init(int M, int N, int G_, int c_, int lda_, int ldb_, int acs_) { nN = N / BM; nwg = (M / BM) * nN; G = G_; c = c_; lda = lda_; ldb = ldb_; acs = acs_; }
    __device__ __forceinline__ bool next(int i, Unit& u) const { const int L = i * G + c; if (L >= nwg) return false; u.pm = L / nN; u.pn = L - u.pm * nN; u.e = 0; return true; }
    __device__ __forceinline__ size_t aoff(const Unit& u) const { return ((size_t)u.pm * BM * lda + (size_t)u.pn * acs) * 2; }
    __device__ __forceinline__ size_t boff(const Unit& u) const { return (size_t)u.pn * BM * ldb * 2; }
    __device__ __forceinline__ const int* rows(const Unit&) const { return nullptr; }
};
struct SchedPw {
    int c, lda, ldb;
    __device__ __forceinline__ bool next(int i, Unit& u) const {
        int L; if (c >= 128) { if (i >= 3) return false; L = 3 * (c - 128) + i; } else { if (i >= 1) return false; L = 384 + c; }
        u.pm = L >> 2; u.pn = L & 3; u.e = 0; return true;
    }
    __device__ __forceinline__ size_t aoff(const Unit& u) const { return (size_t)u.pm * BM * lda * 2; }
    __device__ __forceinline__ size_t boff(const Unit& u) const { return (size_t)u.pn * BM * ldb * 2; }
    __device__ __forceinline__ const int* rows(const Unit&) const { return nullptr; }
};
struct SchedMoe {
    const LAS int* tile_e; const int* row_token; int n_units, npn, G, c, lda, ldb;
    __device__ __forceinline__ bool next(int i, Unit& u) const {
        const long L = (long)i * G + c; if (L >= n_units) return false;
        u.pm = (int)L / npn; u.pn = (int)L % npn; u.e = tile_e[u.pm]; return true;
    }
#ifdef PROBE_HOTAB
    int hot;
    __device__ __forceinline__ size_t aoff(const Unit& u) const { return (hot & 1) ? (size_t)0 : (size_t)u.pm * BM * lda * 2; }
    __device__ __forceinline__ size_t boff(const Unit& u) const { return (hot & 2) ? (size_t)0 : ((size_t)u.e * npn + u.pn) * BM * ldb * 2; }
#else
    __device__ __forceinline__ size_t aoff(const Unit& u) const { return (size_t)u.pm * BM * lda * 2; }
    __device__ __forceinline__ size_t boff(const Unit& u) const { return ((size_t)u.e * npn + u.pn) * BM * ldb * 2; }
#endif
    __device__ __forceinline__ const int* rows(const Unit& u) const { return row_token + (size_t)u.pm * BM; }
};


typedef int v8i_t __attribute__((ext_vector_type(8)));
typedef int v4i_t __attribute__((ext_vector_type(4)));
constexpr int W8_EXP = 121;
template <class Epi, class Sched, bool GATHER, bool FP8 = false>
__device__ __forceinline__ void gemm_phase(LAS unsigned char* lds, const Gemm g, const Sched& S, const Epi& E, LAS unsigned char* van = nullptr) {
    int tid_ = threadIdx.x; asm volatile("" : "+v"(tid_));
    const int tid = tid_, wid = __builtin_amdgcn_readfirstlane(tid >> 6), lane = tid & 63, wr = wid >> 2, wc = wid & 3, fr = lane & 15, fq = lane >> 4;
    const int K = g.K, nt = K / BK;
    unsigned voffA[2], voffB[2];
#pragma unroll
    for (int i = 0; i < 2; ++i) { int R, C; stage_rc(tid * 16 + i * 8192, R, C);
        voffA[i] = (unsigned)(R * g.lda + C) * 2u;
        { const int sg = 64 * (R >> 5) + 16 * ((R >> 2) & 3) + 4 * ((R >> 4) & 1) + (R & 3); voffB[i] = (unsigned)(sg * g.ldb + C) * 2u; } }
    const size_t hstepB = (size_t)8 * g.ldb * 2;
    unsigned vAc[2][2];
    const size_t kstep = (size_t)(BK * 2);
    const size_t hstepA = GATHER ? (size_t)0 : (size_t)HALF * g.lda * 2;
    const unsigned ldsw = (unsigned)wid * 1024u;
    const int aoff = lds_byte(wr * 64 + fr, fq * 8), boff = lds_byte(wc * 32 + fr, fq * 8);
    const int a8o0 = lds_byte(wr * 64 + fr, 16 * (fq & 1)) + (fq >> 1) * 1024;
    const int b8o0 = lds_byte(wc * 32 + fr, 16 * (fq & 1)) + (fq >> 1) * 1024;
    unsigned la8_ = (unsigned)(size_t)lds + (unsigned)a8o0, lb8_ = (unsigned)(size_t)lds + 65536u + (unsigned)b8o0;
    if constexpr (FP8) { asm volatile("" : "+v"(la8_), "+v"(lb8_)); }
    const LAS unsigned char* const la8 = (const LAS unsigned char*)(size_t)la8_; const LAS unsigned char* const lb8 = (const LAS unsigned char*)(size_t)lb8_;
#define PG8_SA(b, h) (((b) * 2 + (h)) * HTB)
#define PG8_SB(b, h) ((4 + (b) * 2 + (h)) * HTB)
#define PG8_STAGE(bufoff, gbase, voff) do { _Pragma("unroll") for (int _i = 0; _i < 2; ++_i) \
        __builtin_amdgcn_global_load_lds((const unsigned*)((const char*)(gbase) + (voff)[_i]), (LAS unsigned*)(lds + (bufoff) + ldsw + _i * 8192), 16, 0, 0); } while (0)
#define PG8_STAGEA(bufoff, gbase, h) do { if constexpr (GATHER) { PG8_STAGE(bufoff, gbase, vAc[h]); } else { PG8_STAGE(bufoff, (gbase) + (h) * hstepA, voffA); } } while (0)

#define PG8_LD32(p) __builtin_shufflevector(*(const LAS v4i_t*)(p), *(const LAS v4i_t*)((p) + 16), 0, 1, 2, 3, 4, 5, 6, 7)
#define PG8_LD8(dst, off0, off1) do { dst = *(const LAS v8i_t*)(lds + (off0)); } while (0)
#define PG8_LDA(dst, b, h) do { if constexpr (FP8) { _Pragma("unroll") for (int m = 0; m < 4; ++m) dst##8[m] = PG8_LD32(la8 + PG8_SA(b, h) + m * 2048); } else { \
        _Pragma("unroll") for (int m = 0; m < 4; ++m) _Pragma("unroll") for (int k = 0; k < 2; ++k) dst[m][k] = *(const LAS bf16x8*)(lds + PG8_SA(b, h) + aoff + m * 2048 + k * 1024); } } while (0)
#define PG8_LDB(dst, b, h) do { if constexpr (FP8) { _Pragma("unroll") for (int n = 0; n < 2; ++n) dst##8[n] = PG8_LD32(lb8 + (PG8_SB(b, h) - 65536) + n * 2048); } else { \
        _Pragma("unroll") for (int n = 0; n < 2; ++n) _Pragma("unroll") for (int k = 0; k < 2; ++k) dst[n][k] = *(const LAS bf16x8*)(lds + PG8_SB(b, h) + boff + n * 2048 + k * 1024); } } while (0)
#define PG8_MMA(ai, bj, At, Bt) do { __builtin_amdgcn_s_setprio(1); if constexpr (FP8) { _Pragma("unroll") for (int m = 0; m < 4; ++m) _Pragma("unroll") for (int n = 0; n < 2; ++n) \
        asm volatile("v_mfma_scale_f32_16x16x128_f8f6f4 %0, %1, %2, %0, %3, %4 op_sel_hi:[0,0,0]" : "+v"(acc[ai][bj][m][n]) : "v"(Bt##8[n]), "v"(At##8[m]), "v"(sclw), "v"(scla)); } else { \
        _Pragma("unroll") for (int m = 0; m < 4; ++m) _Pragma("unroll") for (int n = 0; n < 2; ++n) _Pragma("unroll") for (int k = 0; k < 2; ++k) \
        acc[ai][bj][m][n] = __builtin_amdgcn_mfma_f32_16x16x32_bf16(Bt[n][k], At[m][k], acc[ai][bj][m][n], 0, 0, 0); } __builtin_amdgcn_s_setprio(0); } while (0)
#define PG8_MFMA_DRAIN() do { if constexpr (FP8) asm volatile("s_nop 15\n\ts_nop 7" ::: "memory"); } while (0)
#define PG8_WAIT_V(n) asm volatile("s_waitcnt vmcnt(" #n ")" ::: "memory")
#define PG8_WAIT_L(n) asm volatile("s_waitcnt lgkmcnt(" #n ")" ::: "memory")
#define PG8_BAR __builtin_amdgcn_s_barrier()
#define PG8_SCHED __builtin_amdgcn_sched_barrier(0)
#define PG8_LOADROWS(dst, u) do { const int* _rw = S.rows(u); _Pragma("unroll") for (int _i = 0; _i < 2; ++_i) { int _R, _C; stage_rc(tid * 16 + _i * 8192, _R, _C);   \
        _Pragma("unroll") for (int _h = 0; _h < 2; ++_h) dst[_h][_i] = (unsigned)(_rw[_h * HALF + _R] * g.lda + _C) * 2u; } } while (0)
    Unit cur, nxt; int ui = 0;
    if (!S.next(0, cur)) return;
    f32x4 acc[2][2][4][2];
#pragma unroll
    for (int a = 0; a < 2; ++a)
#pragma unroll
        for (int b = 0; b < 2; ++b)
#pragma unroll
            for (int m = 0; m < 4; ++m)
#pragma unroll
                for (int n = 0; n < 2; ++n) acc[a][b][m][n] = (f32x4){0.f, 0.f, 0.f, 0.f};
    bf16x8 At[4][2], B0[2][2], B1[2][2];
    v8i_t At8[4], B08[2], B18[2];
    int sclw = W8_EXP * 0x01010101, scla = 127 * 0x01010101;
    if constexpr (FP8) { asm volatile("" : "+v"(sclw), "+v"(scla)); }
    const char* cA = (const char*)g.A + (GATHER ? (size_t)0 : S.aoff(cur)); const char* cB = (const char*)g.Bt + S.boff(cur);
    if constexpr (GATHER) { Unit u1; if (wid == 0 && S.next(1, u1))
            __builtin_amdgcn_global_load_lds((const unsigned*)(S.rows(u1) + lane * 4), (LAS unsigned*)(lds + 149504 + 1024), 16, 0, 0);
        PG8_LOADROWS(vAc, cur); }
    PG8_STAGE(PG8_SB(0, 0), cB, voffB); PG8_STAGE(PG8_SB(0, 1), cB + hstepB, voffB); PG8_STAGEA(PG8_SA(0, 0), cA, 0); PG8_STAGEA(PG8_SA(0, 1), cA, 1);
    if (wr == 1) PG8_BAR;
    PG8_WAIT_V(2); PG8_BAR;
    PG8_STAGE(PG8_SB(1, 0), cB + kstep, voffB); PG8_STAGEA(PG8_SA(1, 0), cA + kstep, 0); PG8_STAGE(PG8_SB(1, 1), cB + hstepB + kstep, voffB);
    PG8_WAIT_V(6); PG8_BAR;
    for (;;) {
        const bool has_next = S.next(ui + 1, nxt);
        const char* nA = (has_next && !GATHER) ? (const char*)g.A + S.aoff(nxt) : cA; const char* nB = has_next ? (const char*)g.Bt + S.boff(nxt) : cB;
        if constexpr (GATHER) { Unit u2; if (wid == 0 && S.next(ui + 2, u2))
            __builtin_amdgcn_global_load_lds((const unsigned*)(S.rows(u2) + lane * 4), (LAS unsigned*)(lds + 149504 + (ui & 1) * 1024), 16, 0, 0); }
#pragma clang loop unroll(disable)
        for (int t = 0; t < nt; t += 2) {
            const bool last = (t == nt - 2);
            const char* a1 = cA + (size_t)(t + 1) * kstep;
            const char* a2 = last ? nA : cA + (size_t)(t + 2) * kstep; const char* b2 = last ? nB : cB + (size_t)(t + 2) * kstep;
            const char* a3 = a2 + kstep; const char* b3 = b2 + kstep;
            PG8_LDB(B0, 0, 0); PG8_LDB(B1, 0, 1); PG8_SCHED; PG8_LDA(At, 0, 0); PG8_STAGEA(PG8_SA(1, 1), a1, 1);
            if constexpr (GATHER) { if (last && has_next) { const LAS int* rt_ = (const LAS int*)(lds + 149504 + ((ui + 1) & 1) * 1024);
#pragma unroll
                for (int i_ = 0; i_ < 2; ++i_) { int R_, C_; stage_rc(tid * 16 + i_ * 8192, R_, C_);
#pragma unroll
                    for (int h_ = 0; h_ < 2; ++h_) vAc[h_][i_] = (unsigned)(rt_[h_ * HALF + R_] * g.lda + C_) * 2u; } } }
            PG8_WAIT_V(8); PG8_WAIT_L(0); PG8_BAR; PG8_MMA(0, 0, At, B0); PG8_MMA(0, 1, At, B1); PG8_BAR; PG8_SCHED;
            PG8_LDA(At, 0, 1); PG8_STAGE(PG8_SB(0, 0), b2, voffB); PG8_STAGE(PG8_SB(0, 1), b2 + hstepB, voffB); PG8_STAGEA(PG8_SA(0, 0), a2, 0);
            PG8_WAIT_V(8); PG8_WAIT_L(0); PG8_BAR; PG8_MMA(1, 0, At, B0); PG8_MMA(1, 1, At, B1); PG8_BAR; PG8_SCHED;
            PG8_LDB(B0, 1, 0); PG8_LDB(B1, 1, 1); PG8_SCHED; PG8_LDA(At, 1, 0); PG8_STAGEA(PG8_SA(0, 1), a2, 1);
            PG8_WAIT_V(8); PG8_WAIT_L(0); PG8_BAR; PG8_MMA(0, 0, At, B0); PG8_MMA(0, 1, At, B1); PG8_BAR; PG8_SCHED;
            PG8_LDA(At, 1, 1); PG8_STAGE(PG8_SB(1, 0), b3, voffB); PG8_STAGE(PG8_SB(1, 1), b3 + hstepB, voffB); PG8_STAGEA(PG8_SA(1, 0), a3, 0);
            PG8_WAIT_V(8); PG8_WAIT_L(0); PG8_BAR; PG8_MMA(1, 0, At, B0); PG8_MMA(1, 1, At, B1); PG8_BAR; PG8_SCHED;
        }
        if (wr == 0) PG8_BAR;
        PG8_MFMA_DRAIN();
        E(acc, cur, wr, wc, fr, fq);
        if (!has_next) break;
#pragma unroll
        for (int a = 0; a < 2; ++a)
#pragma unroll
            for (int b = 0; b < 2; ++b)
#pragma unroll
                for (int m = 0; m < 4; ++m)
#pragma unroll
                    for (int n = 0; n < 2; ++n) acc[a][b][m][n] = (f32x4){0.f, 0.f, 0.f, 0.f};
        cur = nxt; cA = nA; cB = nB; ++ui;
        if (wr == 1) PG8_BAR;
    }
    PG8_WAIT_V(0);
    PG8_BAR;
#undef PG8_SA
#undef PG8_SB
#undef PG8_STAGE
#undef PG8_STAGEA
#undef PG8_LDA
#undef PG8_LD8
#undef PG8_LD32
#undef PG8_LDB
#undef PG8_MMA
#undef PG8_MFMA_DRAIN
#undef PG8_WAIT_V
#undef PG8_WAIT_L
#undef PG8_BAR
#undef PG8_SCHED
#undef PG8_LOADROWS
}
}

constexpr int NB = 8, SEQ = 4096, D = 1024, T = NB * SEQ, DEPTH = 4;
constexpr float ALPHA = 1.6817928305074292f;
constexpr float LN_EPS = 1e-5f;
constexpr float NEG_BIG = -1e30f;
constexpr int NEXP = 64, TOPK = 8, EFF = 256;
constexpr int NWAVES = 8, NTHREADS = 512;

constexpr size_t MiB = 1u << 20;
constexpr size_t WS_CTL = 0, CTL_ZERO_BYTES = 1 * MiB;
constexpr size_t WS_ROPE = 1 * MiB;
constexpr size_t WS_LOGITS = 2 * MiB;
constexpr size_t WS_EIDX = 10 * MiB;
constexpr size_t WS_GW = 11 * MiB;
constexpr size_t WS_LRANK = 12 * MiB;
constexpr size_t WS_POSK = 13 * MiB;
constexpr size_t WS_ROWTOK = 14 * MiB;
constexpr size_t WS_BLKHIST = 15 * MiB + 512 * 1024;
constexpr size_t WS_TILEE = 15 * MiB + 640 * 1024;
constexpr size_t WS_MOEMETA = 15 * MiB + 704 * 1024;
constexpr size_t WS_AUX = 16 * MiB;
constexpr size_t WS_MSC = 22 * MiB;
constexpr size_t WS_PBF = 26 * MiB;
constexpr size_t WS_W = 49 * MiB;
constexpr size_t WS_XB0 = 169 * MiB, WS_XB1 = 233 * MiB;
constexpr size_t WS_R1 = 297 * MiB;
constexpr size_t WS_R2 = 905 * MiB;
constexpr size_t WS_X8A = 1057 * MiB, WS_X8B = 1089 * MiB;
constexpr size_t WS_END = 1121 * MiB;
constexpr size_t W_EGU = 0;
constexpr size_t W_EDN = 65 * MiB;
constexpr size_t W_ROUTER = 98 * MiB;
constexpr size_t W_PLEG = 99 * MiB;
constexpr size_t W_PLEW = 101 * MiB;
constexpr size_t W_MIXIN = 102 * MiB;
constexpr size_t W_MIXOUT = 116 * MiB;
constexpr size_t W_CMPK = 118 * MiB;
constexpr size_t W_CMPV = 118 * MiB + 512 * 1024;
constexpr size_t W_CMPB = 119 * MiB;

constexpr int CW_TMO = 0;
constexpr int CW_BAR = 4096;

constexpr int RING_OFF = 0, RING_BYTES = 131072;
constexpr int TAB_OFF = RING_BYTES;
constexpr int MISC_OFF = RING_BYTES + 8192;
constexpr int PTAB_OFF = MISC_OFF + 256;
constexpr int VAN_OFF = MISC_OFF + 1024;
constexpr int LDS_BYTES = 163840;

#define RLX_AGENT __ATOMIC_RELAXED, __HIP_MEMORY_SCOPE_AGENT
#define LDS_WAIT() asm volatile("s_waitcnt lgkmcnt(0)" ::: "memory")
#define VM_WAIT() asm volatile("s_waitcnt vmcnt(0)" ::: "memory")
__device__ __forceinline__ unsigned f2bf(float f) { unsigned u = __builtin_bit_cast(unsigned, f); return (u + 0x7fffu + ((u >> 16) & 1u)) >> 16; }
__device__ __forceinline__ unsigned pk2(float lo, float hi) { return f2bf(lo) | (f2bf(hi) << 16); }

#define XB_TMO      128
#define XB_XCNT(j)  (256  + 64 * (j))
#define XB_XSUB(j)  (1280 + 64 * (j))
#define XB_XGEN(j)  (2304 + 64 * (j))
#define XB_TOP      3328
#define XB_TOPGEN   3392
#define XCD_BAR_WORDS 3456
#define XB_SPIN_CAP (1u << 18)

__device__ __forceinline__ unsigned xb_ld(unsigned* p)              { return __hip_atomic_load(p, __ATOMIC_RELAXED, __HIP_MEMORY_SCOPE_AGENT); }
__device__ __forceinline__ unsigned xb_add(unsigned* p, unsigned v) { return __hip_atomic_fetch_add(p, v, __ATOMIC_RELAXED, __HIP_MEMORY_SCOPE_AGENT); }
__device__ __forceinline__ unsigned xb_xcc_id() { return (unsigned)__builtin_amdgcn_s_getreg((3 << 11) | 20) & 0xFu; }
#define XB_SPIN(cond, bar) do { unsigned _sp = 0; while (cond) { __builtin_amdgcn_s_sleep(1); \
    if ((++_sp & 255u) == 0u) { if (xb_ld(&(bar)[XB_TMO])) break; if (_sp > XB_SPIN_CAP) { atomicAdd(&(bar)[XB_TMO], 1u); break; } } } } while (0)

struct XcdBarrier { unsigned* bar; unsigned x; volatile LAS unsigned* st; };

__device__ __forceinline__ XcdBarrier xcd_barrier_post(unsigned* bar, volatile LAS unsigned* st) {
    XcdBarrier b; b.bar = bar; b.x = xb_xcc_id(); b.st = st;
    if (threadIdx.x == 0) (void)xb_add(&bar[XB_XCNT(b.x)], 1u);
    return b;
}
__device__ __forceinline__ void xcd_barrier_complete(unsigned* bar, unsigned x, unsigned& nloc, unsigned& nx) {
    const unsigned G = gridDim.x * gridDim.y * gridDim.z;
    unsigned sum, cnt, mine, sp = 0u;
    for (;;) {
        sum = 0u; cnt = 0u; mine = 0u;
#pragma unroll
        for (unsigned j = 0; j < 16; ++j) { const unsigned c = xb_ld(&bar[XB_XCNT(j)]); sum += c; cnt += (c > 0u) ? 1u : 0u; mine = (j == x) ? c : mine; }
        if (sum == G) break;
        __builtin_amdgcn_s_sleep(1);
        if ((++sp & 255u) == 0u) { if (xb_ld(&bar[XB_TMO])) break; if (sp > XB_SPIN_CAP) { atomicAdd(&bar[XB_TMO], 1u); break; } }
    }
    nloc = mine > 0u ? mine : 1u; nx = cnt > 0u ? cnt : 1u;
}
__device__ __forceinline__ void xcd_barrier(const XcdBarrier& b) {
    asm volatile("s_waitcnt vmcnt(0)" ::: "memory");
    __syncthreads();
    if (threadIdx.x == 0) {
        unsigned* bar = b.bar; asm volatile("" : "+s"(bar));
        __builtin_amdgcn_s_waitcnt(0);
        unsigned nloc = b.st[0], nx = b.st[1];
        if (nloc == 0u) { xcd_barrier_complete(bar, b.x, nloc, nx); b.st[0] = nloc; b.st[1] = nx; }
        const unsigned old = xb_add(&bar[XB_XSUB(b.x)], 1u);
        const unsigned gen = old / nloc;
        if (old + 1u == (gen + 1u) * nloc) {
            __builtin_amdgcn_fence(__ATOMIC_RELEASE, "agent");
            asm volatile("s_waitcnt vmcnt(0)" ::: "memory");
            const unsigned og = xb_add(&bar[XB_TOP], 1u);
            const unsigned tg = og / nx;
            if (og + 1u == (tg + 1u) * nx) xb_add(&bar[XB_TOPGEN], 1u);
            else XB_SPIN(xb_ld(&bar[XB_TOPGEN]) == tg, bar);
            __builtin_amdgcn_fence(__ATOMIC_ACQUIRE, "agent");
            xb_add(&bar[XB_XGEN(b.x)], 1u);
            asm volatile("s_waitcnt vmcnt(0)" ::: "memory");
        } else {
            XB_SPIN(xb_ld(&bar[XB_XGEN(b.x)]) == gen, bar);
            __builtin_amdgcn_fence(__ATOMIC_ACQUIRE, "agent");
            asm volatile("s_waitcnt vmcnt(0)" ::: "memory");
        }
    }
    __syncthreads();
}

struct Args { const float* in[30]; float* out; unsigned char* ws; int ph_lo, ph_hi; };
struct Frame {
    LAS unsigned char* lds;
    GAS unsigned char* ws;
    unsigned* ctl;
    int tid, lane, wave, ptb;
    __device__ __forceinline__ void refresh() { int t = threadIdx.x; asm volatile("" : "+v"(t)); tid = t; lane = t & 63; wave = __builtin_amdgcn_readfirstlane(t >> 6);
        int z = 0; asm volatile("" : "+v"(z)); ptb = PTAB_OFF + z; }
    int vcu, G;
    GAS float* out;
};

__device__ __forceinline__ const float* ain(const Frame& F, int i) {
    const volatile LAS unsigned* q = (const volatile LAS unsigned*)(F.lds + F.ptb + 8 * i);
    const unsigned lo = __builtin_amdgcn_readfirstlane(q[0]), hi = __builtin_amdgcn_readfirstlane(q[1]);
    return (const float*)(((unsigned long long)hi << 32) | lo);
}
__device__ __forceinline__ const float* ain_g(const Frame& F, int i) {
    const volatile LAS unsigned* q = (const volatile LAS unsigned*)(F.lds + F.ptb + 8 * i);
    const unsigned lo = __builtin_amdgcn_readfirstlane(q[0]), hi = __builtin_amdgcn_readfirstlane(q[1]);
    return (const float*)(GAS const float*)(((unsigned long long)hi << 32) | lo);
}
#define DPP_F(old, src, ctrl, rmask) __builtin_bit_cast(float, __builtin_amdgcn_update_dpp(__builtin_bit_cast(int, (float)(old)), __builtin_bit_cast(int, (float)(src)), ctrl, rmask, 0xf, false))
__device__ __forceinline__ float wave_max_dpp(float v) {
    const float ninf = -3.0e38f;
    v = fmaxf(v, DPP_F(ninf, v, 0x111, 0xf)); v = fmaxf(v, DPP_F(ninf, v, 0x112, 0xf)); v = fmaxf(v, DPP_F(ninf, v, 0x114, 0xf)); v = fmaxf(v, DPP_F(ninf, v, 0x118, 0xf));
    v = fmaxf(v, DPP_F(ninf, v, 0x142, 0xa));
    v = fmaxf(v, DPP_F(ninf, v, 0x143, 0xc));
    return __builtin_bit_cast(float, __builtin_amdgcn_readlane(__builtin_bit_cast(int, v), 63));
}
__device__ __forceinline__ float wave_sum_dpp(float v) {
    v += DPP_F(0.f, v, 0x111, 0xf); v += DPP_F(0.f, v, 0x112, 0xf); v += DPP_F(0.f, v, 0x114, 0xf); v += DPP_F(0.f, v, 0x118, 0xf);
    v += DPP_F(0.f, v, 0x142, 0xa);
    v += DPP_F(0.f, v, 0x143, 0xc);
    return __builtin_bit_cast(float, __builtin_amdgcn_readlane(__builtin_bit_cast(int, v), 63));
}
__device__ __forceinline__ float group8_max_dpp(float v, int lane) {
    v = fmaxf(v, DPP_F(v, v, 0xB1, 0xf));
    v = fmaxf(v, DPP_F(v, v, 0x4E, 0xf));
    const float up = DPP_F(v, v, 0x12C, 0xf), dn = DPP_F(v, v, 0x124, 0xf);
    return fmaxf(v, (lane & 4) ? dn : up);
}
__device__ __forceinline__ float wave_sum(float v) {
#pragma unroll
    for (int o = 1; o < 64; o <<= 1) v += __shfl_xor(v, o);
    return v;
}
__device__ __forceinline__ float wave_max(float v) {
#pragma unroll
    for (int o = 1; o < 64; o <<= 1) v = fmaxf(v, __shfl_xor(v, o));
    return v;
}

enum { IN_X = 0, IN_P, IN_LNG, IN_LNB, IN_MW_IN, IN_MCONV, IN_MIGB, IN_MFGB, IN_MNORMG, IN_MW_OUT, IN_NW_IN, IN_NPOSK, IN_NPOSV, IN_NWK, IN_NWV, IN_NW_OUT,
       IN_DW_IN, IN_DW_OUT, IN_POOLW, IN_POOLS, IN_ROUTER, IN_RBIAS, IN_EG, IN_EU, IN_ED, IN_SG, IN_SU, IN_SD, IN_PLEW, IN_PLEG, N_IN };

__device__ __forceinline__ int rope_phi(int d) { return d < 32 ? 16 * (d >> 3) + (d & 7) : 16 * ((d - 32) >> 3) + 8 + ((d - 32) & 7); }

struct ConvTask { const float* W; bf16_t* WT; long wstride; int K, N, nbatch, ldwt, kind, p0, nitems, pad; };
__device__ __forceinline__ int conv_rowmap(int kind, int p0, int N, int batch, int n) {
    if (kind == 0) return p0 + batch * N + n;
    if (kind == 2) return (batch + (p0 >> 16)) * 512 + (n >> 7) * 256 + 16 * ((n & 127) >> 3) + (n & 7) + (p0 & 0xffff);
    bool rp;
    if (kind == 3) rp = (n < 1024) || (n >= 1536 && n < 1792) || (n >= 2048 && n < 2304); else rp = (n < 6144);
    return rp ? ((n & ~63) + rope_phi(n & 63)) : n;
}
__device__ __forceinline__ void conv_load(const ConvTask& t, int item, int lane, float (&v)[32]) {
    const int nblk = (t.N + 31) / 32, kblk = t.K / 64, per = nblk * kblk;
    const int batch = item / per, r = item % per, kb = r / nblk, nb = r % nblk, k0 = 64 * kb, n0 = 32 * nb;
    const int ncol = n0 + (lane & 31); const bool nok = ncol < t.N;
    const float* W = t.W + (size_t)batch * t.wstride + (size_t)(k0 + (lane >> 5)) * t.N + (nok ? ncol : 0);
#pragma unroll
    for (int i = 0; i < 32; ++i) v[i] = W[(size_t)(2 * i) * t.N];
    if (!nok) {
#pragma unroll
        for (int i = 0; i < 32; ++i) v[i] = 0.f;
    }
}
__device__ __forceinline__ void conv_store(const ConvTask& t, LAS float* scr, int item, int lane, const float (&v)[32]) {
    const int nblk = (t.N + 31) / 32, kblk = t.K / 64, per = nblk * kblk;
    const int batch = item / per, r = item % per, kb = r / nblk, nb = r % nblk, k0 = 64 * kb, n0 = 32 * nb;
#pragma unroll
    for (int i = 0; i < 32; ++i) scr[(2 * i + (lane >> 5)) * 33 + (lane & 31)] = v[i];
    LDS_WAIT(); asm volatile("" ::: "memory");
    const int c = lane & 7;
    const float wsc = (t.kind == 2) ? (((t.p0 & 0xffff) == 0) ? 64.f * 1.44269504f : 64.f * 0.69314718f) : 64.f;
    if (t.pad) {
#pragma unroll
        for (int j = 0; j < 4; ++j) { const int n = (lane >> 3) + 8 * j; const LAS float* s = scr + (8 * c) * 33 + n;
            const unsigned w0 = pk4_fp8(s[0 * 33] * wsc, s[1 * 33] * wsc, s[2 * 33] * wsc, s[3 * 33] * wsc), w1 = pk4_fp8(s[4 * 33] * wsc, s[5 * 33] * wsc, s[6 * 33] * wsc, s[7 * 33] * wsc);
            if (n0 + n < t.N) { const int dr = conv_rowmap(t.kind, t.p0, t.N, batch, n0 + n);
                u32x2 o; o.x = w0; o.y = w1; *(u32x2*)((unsigned char*)t.WT + (size_t)dr * t.ldwt + k0 + 8 * c) = o; } }
    } else {
#pragma unroll
    for (int j = 0; j < 4; ++j) { const int n = (lane >> 3) + 8 * j; const LAS float* s = scr + (8 * c) * 33 + n;
        u32x4 o; o.x = pk2(s[0 * 33], s[1 * 33]); o.y = pk2(s[2 * 33], s[3 * 33]); o.z = pk2(s[4 * 33], s[5 * 33]); o.w = pk2(s[6 * 33], s[7 * 33]);
        if (n0 + n < t.N) { const int dr = conv_rowmap(t.kind, t.p0, t.N, batch, n0 + n);
            *(u32x4*)(t.WT + (size_t)dr * t.ldwt + k0 + 8 * c) = o; } }
    }
    LDS_WAIT(); asm volatile("" ::: "memory");
}
__device__ __forceinline__ void conv_mk(ConvTask& t, const float* W, long wstride, int K, int N, int nbatch, bf16_t* WT, int ldwt, int kind, int p0, int fp8 = 0) {
    t.W = W; t.WT = WT; t.wstride = wstride; t.K = K; t.N = N; t.nbatch = nbatch; t.ldwt = ldwt; t.kind = kind; t.p0 = p0;
    t.nitems = nbatch * (K / 64) * ((N + 31) / 32); t.pad = fp8;
}
__device__ __forceinline__ bool conv_task(const Frame& F, unsigned char* wb, int l, int ti, ConvTask& t) {
    const size_t EW = (size_t)NEXP * D * EFF;
    switch (ti) {
    case 0: conv_mk(t, ain_g(F, IN_EG) + (size_t)l * EW, (long)D * EFF, D, EFF, NEXP, (bf16_t*)(wb + W_EGU), D, 2, 0, 1); return true;
    case 1: conv_mk(t, ain_g(F, IN_EU) + (size_t)l * EW, (long)D * EFF, D, EFF, NEXP, (bf16_t*)(wb + W_EGU), D, 2, 8, 1); return true;
    case 2: conv_mk(t, ain_g(F, IN_SG) + (size_t)l * D * EFF, 0, D, EFF, 1, (bf16_t*)(wb + W_EGU), D, 2, (64 << 16) | 0, 1); return true;
    case 3: conv_mk(t, ain_g(F, IN_SU) + (size_t)l * D * EFF, 0, D, EFF, 1, (bf16_t*)(wb + W_EGU), D, 2, (64 << 16) | 8, 1); return true;
    case 4: conv_mk(t, ain_g(F, IN_ED) + (size_t)l * EW, (long)EFF * D, EFF, D, NEXP, (bf16_t*)(wb + W_EDN), EFF, 0, 0, 1); return true;
    case 5: conv_mk(t, ain_g(F, IN_SD) + (size_t)l * EFF * D, 0, EFF, D, 1, (bf16_t*)(wb + W_EDN), EFF, 0, NEXP * D, 1); return true;
    case 6: conv_mk(t, ain_g(F, IN_ROUTER) + (size_t)l * D * NEXP, 0, D, NEXP, 1, (bf16_t*)(wb + W_ROUTER), D, 0, 0); return true;
    case 7: conv_mk(t, ain_g(F, IN_PLEG) + (size_t)l * D * D, 0, D, D, 1, (bf16_t*)(wb + W_PLEG), D, 0, 0, 1); return true;
    case 8: conv_mk(t, ain_g(F, IN_PLEW) + (size_t)l * 256 * D, 0, 256, D, 1, (bf16_t*)(wb + W_PLEW), 256, 0, 0); return true;
    case 9:
        if (l == 0) conv_mk(t, ain_g(F, IN_MW_IN), 0, D, 3088, 1, (bf16_t*)(wb + W_MIXIN), D, 0, 0);
        else if (l == 1) conv_mk(t, ain_g(F, IN_NW_IN), 0, D, 2608, 1, (bf16_t*)(wb + W_MIXIN), D, 3, 0, 1);
        else if (l == 2) conv_mk(t, ain_g(F, IN_DW_IN), 0, D, 7168, 1, (bf16_t*)(wb + W_MIXIN), D, 4, 0, 1);
        else conv_mk(t, ain_g(F, IN_POOLW), (long)256 * 256, 256, 256, 4, (bf16_t*)(wb + W_MIXOUT), 256, 0, 0);
        return true;
    case 10:
        if (l == 3) return false;
        conv_mk(t, l == 0 ? ain_g(F, IN_MW_OUT) : (l == 1 ? ain_g(F, IN_NW_OUT) : ain_g(F, IN_DW_OUT)), 0, D, D, 1, (bf16_t*)(wb + W_MIXOUT), D, 0, 0, l == 0 ? 0 : 1); return true;
    case 11: if (l != 1) return false; conv_mk(t, ain_g(F, IN_NWK), 0, 2048, 64, 1, (bf16_t*)(wb + W_CMPK), 2048, 0, 0); return true;
    case 12: if (l != 1) return false; conv_mk(t, ain_g(F, IN_NWV), 0, 2048, 64, 1, (bf16_t*)(wb + W_CMPV), 2048, 0, 0); return true;
    default: return false;
    }
}

constexpr unsigned CONV_MASK_LATE = 0xBFu, CONV_MASK_EARLY = 0x1F40u, CONV_MASK_ALL = 0x1FFFu;
__device__ __forceinline__ void phase_convert(Frame& F, const Args& args, int l, unsigned mask, int wi, int NW, bool extras) {
    unsigned char* wb = (unsigned char*)(F.ws + WS_W);
    LAS float* scr = (LAS float*)(F.lds + RING_OFF + F.wave * 16384);
    const int gw = wi * NWAVES + F.wave, NGW = NW * NWAVES;
    int total = 0;
    for (int ti = 0; ti < 13; ++ti) { ConvTask t; if (!conv_task(F, wb, l, ti, t)) break; if ((mask >> ti) & 1u) total += t.nitems; }
    auto decode = [&](int it, ConvTask& t, int& r) -> bool {
        if (it >= total) return false;
        r = it;
        for (int ti = 0; ti < 13; ++ti) { if (!conv_task(F, wb, l, ti, t)) return false; if (!((mask >> ti) & 1u)) continue; if (r < t.nitems) return true; r -= t.nitems; }
        return false;
    };
    {
        int it = gw; ConvTask tc; int rc = 0; bool have = decode(it, tc, rc);
        float cur[32];
        if (have) conv_load(tc, rc, F.lane, cur);
        while (have) {
            const int itn = it + NGW; ConvTask tn; int rn = 0; const bool hn = decode(itn, tn, rn);
            float nxt[32];
            if (hn) conv_load(tn, rn, F.lane, nxt);
            conv_store(tc, scr, rc, F.lane, cur);
            if (hn) {
#pragma unroll
                for (int i = 0; i < 32; ++i) cur[i] = nxt[i];
                tc = tn; rc = rn; }
            have = hn; it = itn;
        }
    }
    if (!extras) return;
    {
        const f32x4* src = (const f32x4*)(ain_g(F, IN_P) + (size_t)l * T * 256);
        u32x2* dst = (u32x2*)(F.ws + WS_PBF);
        const size_t nq = (size_t)T * 256 / 4;
        const size_t st = (size_t)NW * NTHREADS;
        for (size_t i = (size_t)wi * NTHREADS + F.tid; i < nq; i += 4 * st) {
            f32x4 v[4];
#pragma unroll
            for (int u = 0; u < 4; ++u) if (i + u * st < nq) v[u] = src[i + u * st];
#pragma unroll
            for (int u = 0; u < 4; ++u) if (i + u * st < nq) { u32x2 o; o.x = pk2(v[u].x, v[u].y); o.y = pk2(v[u].z, v[u].w); dst[i + u * st] = o; }
        }
    }
    if (l == 0) {
        const f32x4* src = (const f32x4*)ain_g(F, IN_X); u32x2* d16 = (u32x2*)(F.ws + WS_XB0); unsigned* d8 = (unsigned*)(F.ws + WS_X8A);
        const size_t nq = (size_t)T * D / 4;
        const size_t st = (size_t)NW * NTHREADS;
        for (size_t i = (size_t)wi * NTHREADS + F.tid; i < nq; i += 4 * st) {
            f32x4 v[4];
#pragma unroll
            for (int u = 0; u < 4; ++u) if (i + u * st < nq) v[u] = src[i + u * st];
#pragma unroll
            for (int u = 0; u < 4; ++u) if (i + u * st < nq) { u32x2 o; o.x = pk2(v[u].x, v[u].y); o.y = pk2(v[u].z, v[u].w); d16[i + u * st] = o; d8[i + u * st] = pk4_fp8(v[u].x, v[u].y, v[u].z, v[u].w); }
        }
        float* tc = (float*)(F.ws + WS_ROPE); float* tsn = tc + SEQ * 32;
        for (int i = wi * NTHREADS + F.tid; i < SEQ * 32; i += NW * NTHREADS) {
            const int pos = i >> 5, fi = i & 31;
            const float inv = fast_exp2(-(float)fi * (13.287712379549449f / 32.0f));
            const float ang = (float)pos * inv;
            const double rev = (double)ang * 0.15915494309189535; const float fr = (float)(rev - __builtin_rint(rev));
            const float sn = __builtin_amdgcn_sinf(fr), cs = __builtin_amdgcn_cosf(fr);
            tc[i] = cs; tsn[i] = sn;
        }
    }
    if (l == 1 && gw < 128) {
        const int which = gw >> 6, e = gw & 63;
        const float* pe = which ? ain_g(F, IN_NPOSV) : ain_g(F, IN_NPOSK); const float* w = which ? ain_g(F, IN_NWV) : ain_g(F, IN_NWK);
        float s = 0.f;
#pragma unroll
        for (int i = 0; i < 32; ++i) { const int k = 64 * i + F.lane; s += pe[k] * w[(size_t)k * 64 + e]; }
        s = wave_sum(s);
        if (F.lane == 0) ((float*)(F.ws + WS_W + W_CMPB))[which * 64 + e] = s;
    }
}

#define EPI_V(acc, ai, m, j) (acc[ai][(j) >> 3][m][((j) >> 2) & 1][(j) & 3])
constexpr float YM_SCALE = 16.0f, YM_INV = 1.0f / 16.0f;
struct EpiBf16 {
    bf16_t* O; int ldc; const float* colscale; unsigned char* O8;
    __device__ __forceinline__ int nv(const pg8::Unit&) const { return 16; }
    __device__ __forceinline__ void operator()(const f32x4 (&acc)[2][2][4][2], const pg8::Unit& u, int wr, int wc, int fr, int fq) const {
        const int row0 = u.pm * 256 + wr * 64 + fr, col0 = u.pn * 256 + wc * 64 + 16 * fq;
        float sc[16];
#pragma unroll
        for (int j = 0; j < 16; ++j) sc[j] = colscale ? colscale[col0 + j] : 1.0f;
#pragma unroll
        for (int ai = 0; ai < 2; ++ai)
#pragma unroll
            for (int m = 0; m < 4; ++m) { bf16_t* rowp = O + (size_t)(row0 + ai * 128 + m * 16) * ldc + col0;
                if (O8) { u32x4 w8;
#pragma unroll
                    for (int q = 0; q < 4; ++q) w8[q] = pk4_fp8(EPI_V(acc, ai, m, 4 * q) * sc[4 * q] * YM_SCALE, EPI_V(acc, ai, m, 4 * q + 1) * sc[4 * q + 1] * YM_SCALE, EPI_V(acc, ai, m, 4 * q + 2) * sc[4 * q + 2] * YM_SCALE, EPI_V(acc, ai, m, 4 * q + 3) * sc[4 * q + 3] * YM_SCALE);
                    *(u32x4*)(O8 + (size_t)(row0 + ai * 128 + m * 16) * ldc + col0) = w8; continue; }
                u32x4 w0, w1;
#pragma unroll
                for (int q = 0; q < 4; ++q) { w0[q] = cvt_pk_bf16(EPI_V(acc, ai, m, 2 * q) * sc[2 * q], EPI_V(acc, ai, m, 2 * q + 1) * sc[2 * q + 1]);
                    w1[q] = cvt_pk_bf16(EPI_V(acc, ai, m, 8 + 2 * q) * sc[8 + 2 * q], EPI_V(acc, ai, m, 9 + 2 * q) * sc[9 + 2 * q]); }
                *(u32x4*)rowp = w0; *(u32x4*)(rowp + 8) = w1; }
    }
};

constexpr float Y8_SCALE = 32.0f, Y8_INV = 1.0f / 32.0f;
struct EpiY8 {
    unsigned char* Y; int ldc;
#ifdef PROBE_Y8
    int hot;
#endif
    __device__ __forceinline__ int nv(const pg8::Unit&) const { return 8; }
    __device__ __forceinline__ void operator()(const f32x4 (&acc)[2][2][4][2], const pg8::Unit& u, int wr, int wc, int fr, int fq) const {
#ifdef PROBE_Y8
        if (hot == 3) return;
        const int row0 = (hot == 1 ? (u.pm & 63) * 256 : u.pm * 256) + wr * 64 + fr, col0 = u.pn * 256 + wc * 64 + 16 * fq;
#else
        const int row0 = u.pm * 256 + wr * 64 + fr, col0 = u.pn * 256 + wc * 64 + 16 * fq;
#endif
#pragma unroll
        for (int ai = 0; ai < 2; ++ai)
#pragma unroll
            for (int m = 0; m < 4; ++m) { unsigned char* rowp = Y + (size_t)(row0 + ai * 128 + m * 16) * ldc + col0;
                u32x4 st;
#pragma unroll
                for (int q = 0; q < 4; ++q) st[q] = pk4_fp8(EPI_V(acc, ai, m, 4 * q) * Y8_SCALE, EPI_V(acc, ai, m, 4 * q + 1) * Y8_SCALE, EPI_V(acc, ai, m, 4 * q + 2) * Y8_SCALE, EPI_V(acc, ai, m, 4 * q + 3) * Y8_SCALE);
#ifdef PROBE_Y8
                if (hot == 2) { asm volatile("" :: "v"(st)); } else
                if (hot == 4) { *(u32x4*)(Y + (size_t)((u.pm * 4 + u.pn) & 2047) * 65536 + ((wr * 4 + wc) * 8 + ai * 4 + m) * 1024 + (fr >> 1) * 128 + ((fr & 1) * 4 + fq) * 16) = st; } else
#endif
                *(u32x4*)rowp = st; }
    }
};

struct EpiProj {
    bf16_t* O; int ldc; int kind;
    float* gates; int ngate; int gate_pn;
    const float* rc; const float* rs;
    unsigned char* O8;
    __device__ __forceinline__ int nv(const pg8::Unit& u) const { return mode(u.pn) == 2 ? 0 : (O8 ? 8 : 16); }
    __device__ __forceinline__ int mode(int pn) const {
        if (kind == 0) return pn == 12 ? 2 : 0;
        if (kind == 1) return pn == 10 ? 2 : ((pn < 4 || pn == 6 || pn == 8) ? 1 : 0);
        return pn < 24 ? 1 : 0;
    }
    __device__ __forceinline__ void operator()(const f32x4 (&acc)[2][2][4][2], const pg8::Unit& u, int wr, int wc, int fr, int fq) const {
        const int row0 = u.pm * 256 + wr * 64 + fr, col0 = u.pn * 256 + wc * 64 + 16 * fq;
        const int md = mode(u.pn);
        if (md == 2) {
            const int c = wc * 64 + 16 * fq;
            if (c < ngate) {
#pragma unroll
                for (int ai = 0; ai < 2; ++ai)
#pragma unroll
                    for (int m = 0; m < 4; ++m) { float* gp = gates + (size_t)(row0 + ai * 128 + m * 16) * ngate + c;
#pragma unroll
                        for (int q = 0; q < 4; ++q) *(f32x4*)(gp + 4 * q) = (f32x4){EPI_V(acc, ai, m, 4 * q), EPI_V(acc, ai, m, 4 * q + 1), EPI_V(acc, ai, m, 4 * q + 2), EPI_V(acc, ai, m, 4 * q + 3)}; }
            }
        } else if (md == 1) {
#pragma unroll
            for (int ai = 0; ai < 2; ++ai)
#pragma unroll
                for (int m = 0; m < 4; ++m) { const int row = row0 + ai * 128 + m * 16; const int pos = row & (SEQ - 1);
                    const f32x4 c0 = *(const f32x4*)(rc + pos * 32 + 8 * fq), c1 = *(const f32x4*)(rc + pos * 32 + 8 * fq + 4), s0 = *(const f32x4*)(rs + pos * 32 + 8 * fq), s1 = *(const f32x4*)(rs + pos * 32 + 8 * fq + 4);
                    bf16_t* rowp = O + (size_t)row * ldc + col0;
                    float lo[8], hi[8];
#pragma unroll
                    for (int j = 0; j < 8; ++j) { const float x0 = EPI_V(acc, ai, m, j), x1 = EPI_V(acc, ai, m, 8 + j); const float cs = j < 4 ? c0[j] : c1[j - 4], sn = j < 4 ? s0[j] : s1[j - 4];
                        lo[j] = x0 * cs - x1 * sn; hi[j] = x0 * sn + x1 * cs; }
                    if (O8) { u32x4 w8; w8[0] = pk4_fp8(lo[0], lo[1], lo[2], lo[3]); w8[1] = pk4_fp8(lo[4], lo[5], lo[6], lo[7]); w8[2] = pk4_fp8(hi[0], hi[1], hi[2], hi[3]); w8[3] = pk4_fp8(hi[4], hi[5], hi[6], hi[7]);
                        *(u32x4*)(O8 + (size_t)row * ldc + col0) = w8; }
                    else { u32x4 w0, w1;
#pragma unroll
                        for (int q = 0; q < 4; ++q) { w0[q] = cvt_pk_bf16(lo[2 * q], lo[2 * q + 1]); w1[q] = cvt_pk_bf16(hi[2 * q], hi[2 * q + 1]); }
                        *(u32x4*)rowp = w0; *(u32x4*)(rowp + 8) = w1; } }
        } else {
#pragma unroll
            for (int ai = 0; ai < 2; ++ai)
#pragma unroll
                for (int m = 0; m < 4; ++m) { bf16_t* rowp = O + (size_t)(row0 + ai * 128 + m * 16) * ldc + col0;
                    if (O8) { u32x4 w8;
#pragma unroll
                        for (int q = 0; q < 4; ++q) w8[q] = pk4_fp8(EPI_V(acc, ai, m, 4 * q), EPI_V(acc, ai, m, 4 * q + 1), EPI_V(acc, ai, m, 4 * q + 2), EPI_V(acc, ai, m, 4 * q + 3));
                        *(u32x4*)(O8 + (size_t)(row0 + ai * 128 + m * 16) * ldc + col0) = w8; }
                    else { u32x4 w0, w1;
#pragma unroll
                        for (int q = 0; q < 4; ++q) { w0[q] = cvt_pk_bf16(EPI_V(acc, ai, m, 2 * q), EPI_V(acc, ai, m, 2 * q + 1)); w1[q] = cvt_pk_bf16(EPI_V(acc, ai, m, 8 + 2 * q), EPI_V(acc, ai, m, 9 + 2 * q)); }
                        *(u32x4*)rowp = w0; *(u32x4*)(rowp + 8) = w1; } }
        }
    }
};

struct EpiSwiGLU {
    unsigned char* H;
    __device__ __forceinline__ int nv(const pg8::Unit&) const { return 8; }
    __device__ __forceinline__ void operator()(const f32x4 (&acc)[2][2][4][2], const pg8::Unit& u, int wr, int wc, int fr, int fq) const {
        const int row0 = u.pm * 256 + wr * 64 + fr, col0 = u.pn * 128 + wc * 32 + 8 * fq;
#pragma unroll
        for (int ai = 0; ai < 2; ++ai)
#pragma unroll
            for (int m = 0; m < 4; ++m) { unsigned char* rowp = H + (size_t)(row0 + ai * 128 + m * 16) * EFF + col0;
                float r[8];
#pragma unroll
                for (int j = 0; j < 8; ++j) { const float g = EPI_V(acc, ai, m, j), up = EPI_V(acc, ai, m, 8 + j); r[j] = (g * up) * fast_rcp(1.0f + fast_exp2(-g)); }
                u32x2 st; st.x = pk4_fp8(r[0], r[1], r[2], r[3]); st.y = pk4_fp8(r[4], r[5], r[6], r[7]); *(u32x2*)rowp = st; }
    }
};

struct EpiRouter {
    float* L;
    __device__ __forceinline__ int nv(const pg8::Unit&) const { return 0; }
    __device__ __forceinline__ void operator()(const f32x4 (&acc)[2][2][4][2], const pg8::Unit& u, int wr, int wc, int fr, int fq) const {
        if (wc != 0) return;
        const int row0 = u.pm * 256 + wr * 64 + fr, c = 16 * fq;
#pragma unroll
        for (int ai = 0; ai < 2; ++ai)
#pragma unroll
            for (int m = 0; m < 4; ++m) { float* p = L + (size_t)(row0 + ai * 128 + m * 16) * 64 + c;
#pragma unroll
                for (int q = 0; q < 4; ++q) *(f32x4*)(p + 4 * q) = (f32x4){EPI_V(acc, ai, m, 4 * q), EPI_V(acc, ai, m, 4 * q + 1), EPI_V(acc, ai, m, 4 * q + 2), EPI_V(acc, ai, m, 4 * q + 3)}; }
    }
};

struct EpiPLE {
    const bf16_t* X2; const unsigned char* PW; bf16_t* XB; float* XF; unsigned char* X8;
    __device__ __forceinline__ int nv(const pg8::Unit&) const { return 16; }
    __device__ __forceinline__ void operator()(const f32x4 (&acc)[2][2][4][2], const pg8::Unit& u, int wr, int wc, int fr, int fq) const {
        const int row0 = u.pm * 256 + wr * 64 + fr, col0 = u.pn * 256 + wc * 64 + 16 * fq;
#pragma unroll
        for (int ai = 0; ai < 2; ++ai)
#pragma unroll
            for (int m = 0; m < 4; ++m) { const size_t o = (size_t)(row0 + ai * 128 + m * 16) * D + col0;
                const u32x4 xa = *(const u32x4*)(X2 + o), xb2 = *(const u32x4*)(X2 + o + 8), p8 = *(const u32x4*)(PW + o);
                float r[16], pvv[16];
#pragma unroll
                for (int q = 0; q < 4; ++q) { const f32x2 plo = __builtin_amdgcn_cvt_pk_f32_fp8((int)p8[q], false), phi = __builtin_amdgcn_cvt_pk_f32_fp8((int)p8[q], true);
                    pvv[4 * q] = plo.x; pvv[4 * q + 1] = plo.y; pvv[4 * q + 2] = phi.x; pvv[4 * q + 3] = phi.y; }
#pragma unroll
                for (int j = 0; j < 16; ++j) { const unsigned xw = j < 8 ? xa[j >> 1] : xb2[(j - 8) >> 1];
                    const float xv = (j & 1) ? bfhi(xw) : bflo(xw);
                    r[j] = xv + sigmoidf_(EPI_V(acc, ai, m, j)) * pvv[j]; }
                if (XF) {
#pragma unroll
                    for (int q = 0; q < 4; ++q) *(f32x4*)(XF + o + 4 * q) = (f32x4){r[4 * q], r[4 * q + 1], r[4 * q + 2], r[4 * q + 3]}; }
                u32x4 w0, w1, w8;
#pragma unroll
                for (int q = 0; q < 4; ++q) { w0[q] = cvt_pk_bf16(r[2 * q], r[2 * q + 1]); w1[q] = cvt_pk_bf16(r[8 + 2 * q], r[9 + 2 * q]); w8[q] = pk4_fp8(r[4 * q], r[4 * q + 1], r[4 * q + 2], r[4 * q + 3]); }
                *(u32x4*)(XB + o) = w0; *(u32x4*)(XB + o + 8) = w1; *(u32x4*)(X8 + o) = w8; }
    }
};

__device__ __forceinline__ void ln_acc_bf16(float (&v)[16], const bf16_t* row, float w, int lane) {
    const u32x4 a = *(const u32x4*)(row + 16 * lane), b = *(const u32x4*)(row + 16 * lane + 8);
    v[0] += w * bflo(a.x); v[1] += w * bfhi(a.x); v[2] += w * bflo(a.y); v[3] += w * bfhi(a.y); v[4] += w * bflo(a.z); v[5] += w * bfhi(a.z); v[6] += w * bflo(a.w); v[7] += w * bfhi(a.w);
    v[8] += w * bflo(b.x); v[9] += w * bfhi(b.x); v[10] += w * bflo(b.y); v[11] += w * bfhi(b.y); v[12] += w * bflo(b.z); v[13] += w * bfhi(b.z); v[14] += w * bflo(b.w); v[15] += w * bfhi(b.w);
}
__device__ __forceinline__ void ln_acc_fp8(float (&v)[16], const unsigned char* row, float w, int lane) {
    const u32x4 a = *(const u32x4*)(row + 16 * lane);
#pragma unroll
    for (int q = 0; q < 4; ++q) { const f32x2 lo = __builtin_amdgcn_cvt_pk_f32_fp8((int)a[q], false), hi = __builtin_amdgcn_cvt_pk_f32_fp8((int)a[q], true);
        v[4 * q] += w * lo.x; v[4 * q + 1] += w * lo.y; v[4 * q + 2] += w * hi.x; v[4 * q + 3] += w * hi.y; }
}
template <int MODE>
__device__ __forceinline__ void phase_ln(Frame& F, const bf16_t* Xin, const void* Ysrc, const float* g, const float* b, bf16_t* XB,
                                         const int* posk, const float* gwt, int shbase, unsigned char* X8 = nullptr) {
    const int gw = F.vcu * NWAVES + F.wave, NGW = F.G * NWAVES, lane = F.lane;
    f32x4 gg[4], bb[4];
#pragma unroll
    for (int j = 0; j < 4; ++j) { gg[j] = *(const f32x4*)(g + 16 * lane + 4 * j); bb[j] = *(const f32x4*)(b + 16 * lane + 4 * j); }
    int pkn = 0; float wkn = 0.f;
    if (MODE == 2 && gw < T && lane < 8) { pkn = posk[(size_t)gw * 8 + lane]; wkn = gwt[(size_t)gw * 8 + lane]; }
    for (int row = gw; row < T; row += NGW) {
        float v[16];
#pragma unroll
        for (int i = 0; i < 16; ++i) v[i] = 0.f;
        int pk = pkn; float wk = wkn * Y8_INV;
        if (MODE == 2 && row + NGW < T && lane < 8) { pkn = posk[(size_t)(row + NGW) * 8 + lane]; wkn = gwt[(size_t)(row + NGW) * 8 + lane]; }
        ln_acc_bf16(v, Xin + (size_t)row * D, ALPHA, lane);
        if (MODE == 1) ln_acc_fp8(v, (const unsigned char*)Ysrc + (size_t)row * D, YM_INV, lane);
        else if (MODE == 2) {
#pragma unroll
            for (int k = 0; k < 9; ++k) {
                const int p = (k < 8) ? __shfl(pk, k) : (shbase + row); const float w8 = (k < 8) ? __shfl(wk, k) : Y8_INV;
                ln_acc_fp8(v, (const unsigned char*)Ysrc + (size_t)p * D, w8, lane);
            }
        }
        float s = 0.f;
#pragma unroll
        for (int i = 0; i < 16; ++i) s += v[i];
        const float mean = wave_sum(s) * (1.f / D); float s2 = 0.f;
#pragma unroll
        for (int i = 0; i < 16; ++i) { v[i] -= mean; s2 += v[i] * v[i]; }
        const float rstd = frsq(wave_sum(s2) * (1.f / D) + LN_EPS);
        u32x4 o0, o1, o8;
#pragma unroll
        for (int q = 0; q < 4; ++q) { const float a0 = v[4 * q] * rstd * gg[q][0] + bb[q][0], a1 = v[4 * q + 1] * rstd * gg[q][1] + bb[q][1], a2 = v[4 * q + 2] * rstd * gg[q][2] + bb[q][2], a3 = v[4 * q + 3] * rstd * gg[q][3] + bb[q][3];
            const unsigned w0 = cvt_pk_bf16(a0, a1), w1 = cvt_pk_bf16(a2, a3); o8[q] = pk4_fp8(a0, a1, a2, a3);
            if (q < 2) { o0[2 * q] = w0; o0[2 * q + 1] = w1; } else { o1[2 * (q - 2)] = w0; o1[2 * (q - 2) + 1] = w1; } }
        bf16_t* xbr = XB + (size_t)row * D + 16 * lane;
        *(u32x4*)xbr = o0; *(u32x4*)(xbr + 8) = o1;
        if (X8) *(u32x4*)(X8 + (size_t)row * D + 16 * lane) = o8;
    }
}

__device__ __forceinline__ void phase_route1(Frame& F, const float* logits, const float* rbias, int* eidx, float* gwt, int* lrank, int* blk_hist) {
    LAS int* hist = (LAS int*)(F.lds + RING_OFF);
    const int lane = F.lane;
    const float bias = rbias[lane];
    for (int chunk = blockIdx.x; chunk < T / 128; chunk += F.G) {
        if (F.tid < 64) hist[F.tid] = 0;
        __syncthreads();
        for (int i0 = 0; i0 < 16; i0 += 4) {
            float score[4], val[4]; int tk[4];
#pragma unroll
            for (int u = 0; u < 4; ++u) {
                const int t = chunk * 128 + F.wave * 16 + i0 + u; tk[u] = t;
                const float lg = logits[(size_t)t * 64 + lane];
                score[u] = fast_rcp(1.0f + fexp(-lg));
            }
#pragma unroll
            for (int u = 0; u < 4; ++u) {
                const float biased = score[u] + bias;
                const float m1 = group8_max_dpp(biased, lane);
                const unsigned long long bm = __ballot(biased == m1);
                const int grp = lane >> 3;
                const unsigned gb = (unsigned)((bm >> (8 * grp)) & 0xffull);
                const int firstmax = 8 * grp + (__ffs((int)gb) - 1);
                const float m2 = group8_max_dpp((lane == firstmax) ? -3.0e38f : biased, lane);
                const float gs = m1 + m2;
                int cnt = 0;
#pragma unroll
                for (int g2 = 0; g2 < 8; ++g2) { const float sc = __builtin_bit_cast(float, __builtin_amdgcn_readlane(__builtin_bit_cast(int, gs), 8 * g2)); cnt += (sc > gs || (sc == gs && g2 < grp)) ? 1 : 0; }
                val[u] = (cnt < 4) ? biased : NEG_BIG;
            }
            bool taken[4]; int myk[4];
#pragma unroll
            for (int u = 0; u < 4; ++u) { taken[u] = false; myk[u] = 0; }
#pragma unroll
            for (int k = 0; k < 8; ++k) {
#pragma unroll
                for (int u = 0; u < 4; ++u) {
                    const float cand = taken[u] ? -3.0e38f : val[u];
                    const float mx = wave_max_dpp(cand);
                    const unsigned long long bal = __ballot(cand == mx);
                    const int win = __ffsll((long long)bal) - 1;
                    if (lane == win) { taken[u] = true; myk[u] = k; }
                }
            }
#pragma unroll
            for (int u = 0; u < 4; ++u) {
                const float sw = wave_sum_dpp(taken[u] ? score[u] : 0.f);
                if (taken[u]) {
                    const int lr = __hip_atomic_fetch_add(hist + lane, 1, __ATOMIC_RELAXED, __HIP_MEMORY_SCOPE_WORKGROUP);
                    const size_t o = (size_t)tk[u] * 8 + myk[u];
                    eidx[o] = lane; gwt[o] = score[u] * fast_rcp(sw) * 2.5f; lrank[o] = lr;
                }
            }
        }
        __syncthreads();
        if (F.tid < 64) blk_hist[chunk * 64 + F.tid] = hist[F.tid];
        __syncthreads();
    }
}
__device__ __forceinline__ void phase_route2(Frame& F, const int* eidx, const int* lrank, const int* blk_hist, int* posk, int* row_token, int* tile_e, int* meta) {
    LAS int* cnt = (LAS int*)(F.lds + RING_OFF); LAS int* base = cnt + 64; LAS int* off = cnt + 128;
    LAS int* pc_ = cnt + 256; LAS int* pb_ = cnt + 768;
    for (int chunk = blockIdx.x; chunk < T / 128; chunk += F.G) {
        __syncthreads();
        { const int e = F.tid & 63, part = F.tid >> 6; int c = 0, bs = 0;
#pragma unroll 8
          for (int i = 0; i < 32; ++i) { const int b2 = 32 * part + i; const int h = blk_hist[b2 * 64 + e]; c += h; bs += (b2 < chunk) ? h : 0; }
          pc_[part * 64 + e] = c; pb_[part * 64 + e] = bs; }
        __syncthreads();
        if (F.tid < 64) { int c = 0, bs = 0;
#pragma unroll
          for (int q = 0; q < 8; ++q) { c += pc_[q * 64 + F.tid]; bs += pb_[q * 64 + F.tid]; }
          cnt[F.tid] = c; base[F.tid] = bs; }
        __syncthreads();
        if (F.tid == 0) { int o = 0; for (int e = 0; e < 64; ++e) { off[e] = o; o += (cnt[e] + 255) & ~255; } off[64] = o; }
        __syncthreads();
        for (int a = F.tid; a < 128 * 8; a += NTHREADS) {
            const size_t ga = (size_t)chunk * 1024 + a; const int e = eidx[ga]; const int pos = off[e] + base[e] + lrank[ga];
            posk[ga] = pos; row_token[pos] = (int)(ga >> 3);
        }
        if (F.tid < 128) row_token[off[64] + chunk * 128 + F.tid] = chunk * 128 + F.tid;
        if (chunk < 64) {
            const int e = chunk;
            for (int r = off[e] + cnt[e] + F.tid; r < off[e + 1]; r += NTHREADS) row_token[r] = 0;
            for (int tl = off[e] / 256 + F.tid; tl < off[e + 1] / 256; tl += NTHREADS) tile_e[tl] = e;
        } else if (chunk == 64) {
            if (F.tid < 128) tile_e[off[64] / 256 + F.tid] = 64;
            if (F.tid == 0) { meta[0] = off[64]; meta[1] = off[64] / 256 + T / 256; }
        }
    }
    __syncthreads();
}


__device__ __forceinline__ bf16x8 frag_row(const LAS unsigned char* base, int ldb, int r0, int k0, int lane) {
    return *(const LAS bf16x8*)(base + (r0 + (lane & 15)) * ldb + (k0 + 8 * (lane >> 4)) * 2);
}
__device__ __forceinline__ bf16x8 frag_tr(const LAS unsigned char* base, int ldb, int rowA, int rowB, int c0, int lane) {
    const int q = (lane & 15) >> 2, p = lane & 3;
    const unsigned a0 = (unsigned)(size_t)(base + (rowA + q) * ldb + (c0 + 4 * p) * 2);
    const unsigned a1 = (unsigned)(size_t)(base + (rowB + q) * ldb + (c0 + 4 * p) * 2);
    bf16x4 lo, hi;
    asm volatile("ds_read_b64_tr_b16 %0, %2\n\tds_read_b64_tr_b16 %1, %3\n\ts_waitcnt lgkmcnt(0)" : "=&v"(lo), "=&v"(hi) : "v"(a0), "v"(a1) : "memory");
    bf16x8 r; r[0] = lo[0]; r[1] = lo[1]; r[2] = lo[2]; r[3] = lo[3]; r[4] = hi[0]; r[5] = hi[1]; r[6] = hi[2]; r[7] = hi[3];
    return r;
}
__device__ __forceinline__ bf16x8 pack_bf16x8(const f32x4 a, const f32x4 b) {
    u32x4 w; w.x = cvt_pk_bf16(a[0], a[1]); w.y = cvt_pk_bf16(a[2], a[3]); w.z = cvt_pk_bf16(b[0], b[1]); w.w = cvt_pk_bf16(b[2], b[3]);
    return __builtin_bit_cast(bf16x8, w);
}
template <int LD>
__device__ __forceinline__ void frag_tr4(const LAS unsigned char* base, int rowA, int lane, bf16x8 (&out)[4]) {
    const int q = (lane & 15) >> 2, p = lane & 3;
    const unsigned a0 = (unsigned)(size_t)(base + (rowA + q) * LD + 8 * p);
    bf16x4 r0, r1, r2, r3, r4, r5, r6, r7;
    asm volatile("ds_read_b64_tr_b16 %0, %8\n\tds_read_b64_tr_b16 %1, %8 offset:%9\n\tds_read_b64_tr_b16 %2, %8 offset:32\n\tds_read_b64_tr_b16 %3, %8 offset:%10\n\t"
                 "ds_read_b64_tr_b16 %4, %8 offset:64\n\tds_read_b64_tr_b16 %5, %8 offset:%11\n\tds_read_b64_tr_b16 %6, %8 offset:96\n\tds_read_b64_tr_b16 %7, %8 offset:%12\n\ts_waitcnt lgkmcnt(0)"
                 : "=&v"(r0), "=&v"(r1), "=&v"(r2), "=&v"(r3), "=&v"(r4), "=&v"(r5), "=&v"(r6), "=&v"(r7)
                 : "v"(a0), "n"(16 * LD), "n"(16 * LD + 32), "n"(16 * LD + 64), "n"(16 * LD + 96) : "memory");
    out[0] = __builtin_shufflevector(r0, r1, 0, 1, 2, 3, 4, 5, 6, 7); out[1] = __builtin_shufflevector(r2, r3, 0, 1, 2, 3, 4, 5, 6, 7);
    out[2] = __builtin_shufflevector(r4, r5, 0, 1, 2, 3, 4, 5, 6, 7); out[3] = __builtin_shufflevector(r6, r7, 0, 1, 2, 3, 4, 5, 6, 7);
}
#define MFMA16(a, b, c) __builtin_amdgcn_mfma_f32_16x16x32_bf16(a, b, c, 0, 0, 0)
__device__ __forceinline__ float logsigmoidf_(float x) { return fminf(x, 0.f) - flog(1.0f + fexp(-fabsf(x))); }


constexpr int DLP = 7168, DL_LD = 144, DL_ROWS = 288;
constexpr float SM_C = 0.125f * 1.44269504f;
__device__ __forceinline__ bf16x8 fp8x8_to_bf16(unsigned a, unsigned b) {
    const f32x2 p0 = __builtin_amdgcn_cvt_pk_f32_fp8((int)a, false), p1 = __builtin_amdgcn_cvt_pk_f32_fp8((int)a, true), p2 = __builtin_amdgcn_cvt_pk_f32_fp8((int)b, false), p3 = __builtin_amdgcn_cvt_pk_f32_fp8((int)b, true);
    u32x4 w; w.x = cvt_pk_bf16(p0.x, p0.y); w.y = cvt_pk_bf16(p1.x, p1.y); w.z = cvt_pk_bf16(p2.x, p2.y); w.w = cvt_pk_bf16(p3.x, p3.y);
    return __builtin_bit_cast(bf16x8, w);
}
constexpr float OG_SCALE = 16.0f, OG_INV = 1.0f / 16.0f;
__device__ __forceinline__ void phase_dilated_attn(Frame& F, const unsigned char* proj, unsigned char* og0, unsigned char* og1, unsigned char* og2, float* lse) {
    LAS unsigned char* kt = F.lds + RING_OFF;
    LAS unsigned char* vt = F.lds + RING_OFF + DL_ROWS * DL_LD;
    const int lane = F.lane, w = F.wave, tid = F.tid, gq = lane >> 4, tq = lane & 15;
    unsigned zz = 0u; asm volatile("" : "+v"(zz));
    const u32x4 zero4 = (u32x4){zz, zz, zz, zz};
    for (int pc = tid; pc < 2 * 32 * 9; pc += NTHREADS) { const int tn = pc / (32 * 9), r = pc % (32 * 9);
        *(LAS u32x4*)(F.lds + RING_OFF + tn * DL_ROWS * DL_LD + 256 * DL_LD + r * 16) = zero4; }
    constexpr int NITEMS = 3 * NB * 16 * 32;
    u32x4 pre[4]; u32x2 qra, qrb; size_t qtok_n = 0;
    auto prefetch = [&](int item) {
        const int idx = (item >> 1) & 31, head = ((item >> 6) & 7) * 2 + (item & 1), b = (item >> 9) & 7, grp = item >> 12;
        const int dsh = 2 * grp, dil = 1 << dsh, r = idx & (dil - 1), jt = idx >> dsh;
        const unsigned char* pb = proj + (size_t)b * SEQ * DLP;
        const int qcol = 2 * grp * 1024 + head * 64, kcol = qcol + 1024, vcol = 6144 + head * 64;
#pragma unroll
        for (int i = 0; i < 4; ++i) { const int pc = tid + i * 512, tn = pc >> 10, rr = pc & 1023, j = rr >> 2, d16 = (rr & 3) * 16;
            const int ik = 128 * jt - 128 + j; u32x4 val = zero4;
            if (ik >= 0) val = *(const u32x4*)(pb + (size_t)((ik << dsh) + r) * DLP + (tn ? vcol : kcol) + d16);
            pre[i] = val; }
        const int iq = 16 * w + tq;
        qtok_n = (size_t)b * SEQ + (size_t)(((128 * jt + iq) << dsh) + r);
        qra = *(const u32x2*)(proj + qtok_n * DLP + qcol + 8 * gq); qrb = *(const u32x2*)(proj + qtok_n * DLP + qcol + 32 + 8 * gq);
    };
    if (F.vcu < NITEMS) prefetch(F.vcu);
    for (int item = F.vcu; item < NITEMS; item += F.G) {
        const int idx = (item >> 1) & 31, head = ((item >> 6) & 7) * 2 + (item & 1), grp = item >> 12;
        const int dsh = 2 * grp, jt = idx >> dsh;
        __syncthreads();
#pragma unroll
        for (int i = 0; i < 4; ++i) { const int pc = tid + i * 512, tn = pc >> 10, rr = pc & 1023, j = rr >> 2, d16 = (rr & 3) * 16;
            LAS unsigned char* dst = F.lds + RING_OFF + tn * DL_ROWS * DL_LD + j * DL_LD + d16 * 2;
            *(LAS bf16x8*)dst = fp8x8_to_bf16(pre[i].x, pre[i].y); *(LAS bf16x8*)(dst + 16) = fp8x8_to_bf16(pre[i].z, pre[i].w); }
        const int iq = 16 * w + tq;
        const size_t qtok = qtok_n; const bf16x8 qf0 = fp8x8_to_bf16(qra.x, qra.y), qf1 = fp8x8_to_bf16(qrb.x, qrb.y);
        __syncthreads();
        if (item + F.G < NITEMS) prefetch(item + F.G);
        f32x4 acc[4];
#pragma unroll
        for (int n = 0; n < 4; ++n) acc[n] = (f32x4){0.f, 0.f, 0.f, 0.f};
        float mrun = NEG_BIG, lrun = 0.f;
        auto qk = [&](int kb, f32x4 (&s)[2]) {
            const int j0 = 16 * w + 32 * kb;
#pragma unroll
            for (int h2 = 0; h2 < 2; ++h2) { f32x4 z = (f32x4){0.f, 0.f, 0.f, 0.f};
                z = MFMA16(frag_row(kt, DL_LD, j0 + 16 * h2, 0, lane), qf0, z);
                z = MFMA16(frag_row(kt, DL_LD, j0 + 16 * h2, 32, lane), qf1, z);
                s[h2] = z; }
        };
        f32x4 sn[2]; qk(0, sn);
#pragma unroll
        for (int kb = 0; kb < 5; ++kb) {
            const int j0 = 16 * w + 32 * kb;
            f32x4 s[2] = {sn[0], sn[1]};
            if (kb < 4) qk(kb + 1, sn);
            if (kb == 0 || kb == 4 || jt == 0) {
#pragma unroll
                for (int h2 = 0; h2 < 2; ++h2)
#pragma unroll
                    for (int rr = 0; rr < 4; ++rr) { const int j = j0 + 16 * h2 + 4 * gq + rr; const int dd = iq + 128 - j;
                        const bool ok = (dd >= 0) && (dd <= 128) && (128 * jt - 128 + j >= 0);
                        s[h2][rr] = ok ? s[h2][rr] : -3.0e38f; }
            }
            float mx = fmaxf(fmaxf(fmaxf(s[0][0], s[0][1]), fmaxf(s[0][2], s[0][3])), fmaxf(fmaxf(s[1][0], s[1][1]), fmaxf(s[1][2], s[1][3])));
            mx = fmaxf(mx * SM_C, NEG_BIG);
            if (__any(mx > mrun + 8.0f)) {
                mx = fmaxf(mx, __shfl_xor(mx, 16)); mx = fmaxf(mx, __shfl_xor(mx, 32));
                const float mnew = fmaxf(mrun, mx), alpha = fast_exp2(mrun - mnew);
                lrun *= alpha; mrun = mnew;
#pragma unroll
                for (int n = 0; n < 4; ++n) acc[n] = acc[n] * alpha;
            }
            const float negm = -mrun;
            float ps = 0.f;
#pragma unroll
            for (int h2 = 0; h2 < 2; ++h2)
#pragma unroll
                for (int rr = 0; rr < 4; ++rr) { const float pe = fast_exp2(__builtin_fmaf(s[h2][rr], SM_C, negm)); s[h2][rr] = pe; ps += pe; }
            lrun += ps;
            const bf16x8 pf = pack_bf16x8(s[0], s[1]);
            bf16x8 vf[4]; frag_tr4<DL_LD>(vt, j0 + 4 * gq, lane, vf);
#pragma unroll
            for (int n = 0; n < 4; ++n) acc[n] = MFMA16(vf[n], pf, acc[n]);
        }
        lrun += __shfl_xor(lrun, 16); lrun += __shfl_xor(lrun, 32);
        const float inv = fast_rcp(lrun) * OG_SCALE;
        unsigned char* og = grp == 0 ? og0 : (grp == 1 ? og1 : og2);
#pragma unroll
        for (int n = 0; n < 4; ++n) *(unsigned*)(og + qtok * D + head * 64 + 16 * n + 4 * gq) = pk4_fp8(acc[n][0] * inv, acc[n][1] * inv, acc[n][2] * inv, acc[n][3] * inv);
        if (gq == 0) lse[((size_t)grp * T + qtok) * 16 + head] = mrun * 0.69314718f + flog(lrun);
    }
    __syncthreads();
}
__device__ __forceinline__ void phase_dilated_combine(Frame& F, const unsigned char* og0, const unsigned char* og1, const unsigned char* og2, const float* lse, unsigned char* Out) {
#pragma unroll 2
    for (size_t i = (size_t)blockIdx.x * NTHREADS + F.tid; i < (size_t)T * 128; i += (size_t)F.G * NTHREADS) {
        const size_t tok = i >> 7; const int pc = (int)(i & 127), head = pc >> 3;
        const float l0 = lse[tok * 16 + head], l1 = lse[((size_t)T + tok) * 16 + head], l2 = lse[((size_t)2 * T + tok) * 16 + head];
        const float mx = fmaxf(l0, fmaxf(l1, l2));
        float w0 = fexp(l0 - mx), w1 = fexp(l1 - mx), w2 = fexp(l2 - mx); const float inv = fast_rcp(w0 + w1 + w2) * OG_INV; w0 *= inv; w1 *= inv; w2 *= inv;
        const u32x2 a = *(const u32x2*)(og0 + tok * D + pc * 8), bq = *(const u32x2*)(og1 + tok * D + pc * 8), c = *(const u32x2*)(og2 + tok * D + pc * 8);
        u32x2 o;
#pragma unroll
        for (int h = 0; h < 2; ++h) {
            const f32x2 a0 = __builtin_amdgcn_cvt_pk_f32_fp8((int)a[h], false), a1 = __builtin_amdgcn_cvt_pk_f32_fp8((int)a[h], true);
            const f32x2 b0 = __builtin_amdgcn_cvt_pk_f32_fp8((int)bq[h], false), b1 = __builtin_amdgcn_cvt_pk_f32_fp8((int)bq[h], true);
            const f32x2 c0 = __builtin_amdgcn_cvt_pk_f32_fp8((int)c[h], false), c1 = __builtin_amdgcn_cvt_pk_f32_fp8((int)c[h], true);
            o[h] = pk4_fp8(w0 * a0.x + w1 * b0.x + w2 * c0.x, w0 * a0.y + w1 * b0.y + w2 * c0.y, w0 * a1.x + w1 * b1.x + w2 * c1.x, w0 * a1.y + w1 * b1.y + w2 * c1.y); }
        *(u32x2*)(Out + tok * D + pc * 8) = o;
    }
}

constexpr int ML_LDQ = 144, ML_LDV = 272;
constexpr int MLP = 3072;
__device__ __forceinline__ void ml_conv_piece(const bf16_t* proj, const float* convw, int b, int c, int s, int colbase, int d8, float scale, LAS unsigned char* tile) {
    float acc[8];
#pragma unroll
    for (int i = 0; i < 8; ++i) acc[i] = 0.f;
#pragma unroll
    for (int j = 0; j < 4; ++j) {
        const int sp = 64 * c + s - 3 + j;
        if (sp >= 0) {
            const u32x4 x = *(const u32x4*)(proj + ((size_t)b * SEQ + sp) * MLP + colbase + d8);
            const f32x4 w0 = *(const f32x4*)(convw + j * 1024 + colbase + d8), w1 = *(const f32x4*)(convw + j * 1024 + colbase + d8 + 4);
            acc[0] += bflo(x.x) * w0[0]; acc[1] += bfhi(x.x) * w0[1]; acc[2] += bflo(x.y) * w0[2]; acc[3] += bfhi(x.y) * w0[3];
            acc[4] += bflo(x.z) * w1[0]; acc[5] += bfhi(x.z) * w1[1]; acc[6] += bflo(x.w) * w1[2]; acc[7] += bfhi(x.w) * w1[3];
        }
    }
#pragma unroll
    for (int i = 0; i < 8; ++i) acc[i] = acc[i] * sigmoidf_(acc[i]) * scale;
    u32x4 o; o.x = cvt_pk_bf16(acc[0], acc[1]); o.y = cvt_pk_bf16(acc[2], acc[3]); o.z = cvt_pk_bf16(acc[4], acc[5]); o.w = cvt_pk_bf16(acc[6], acc[7]);
    *(LAS u32x4*)(tile + s * ML_LDQ + d8 * 2) = o;
}
__device__ __forceinline__ void ml_gate_scan(const float* gates, const float* igb, const float* fgb, int b, int h, int c, int lane, float& bcum, float& a, float& g) {
    const size_t t = (size_t)b * SEQ + 64 * c + lane;
    const float ig = gates[t * 16 + h] + igb[h];
    const float lf = logsigmoidf_(gates[t * 16 + 8 + h] + fgb[h]);
    float v = lf;
#pragma unroll
    for (int o = 1; o < 64; o <<= 1) { const float u = __shfl_up(v, o); if (lane >= o) v += u; }
    bcum = v; a = ig - v;
    float m = a;
#pragma unroll
    for (int o = 1; o < 64; o <<= 1) { const float u = __shfl_up(m, o); if (lane >= o) m = fmaxf(m, u); }
    g = m;
}

__device__ __forceinline__ void ml_conv_piece_pre(const u32x4 (&x)[4], const float* convw, int s, int colbase, int d8, float scale, LAS unsigned char* tile) {
    float acc[8];
#pragma unroll
    for (int i = 0; i < 8; ++i) acc[i] = 0.f;
#pragma unroll
    for (int j = 0; j < 4; ++j) {
        const f32x4 w0 = *(const f32x4*)(convw + j * 1024 + colbase + d8), w1 = *(const f32x4*)(convw + j * 1024 + colbase + d8 + 4);
        acc[0] += bflo(x[j].x) * w0[0]; acc[1] += bfhi(x[j].x) * w0[1]; acc[2] += bflo(x[j].y) * w0[2]; acc[3] += bfhi(x[j].y) * w0[3];
        acc[4] += bflo(x[j].z) * w1[0]; acc[5] += bfhi(x[j].z) * w1[1]; acc[6] += bflo(x[j].w) * w1[2]; acc[7] += bfhi(x[j].w) * w1[3];
    }
#pragma unroll
    for (int i = 0; i < 8; ++i) acc[i] = acc[i] * sigmoidf_(acc[i]) * scale;
    u32x4 o; o.x = cvt_pk_bf16(acc[0], acc[1]); o.y = cvt_pk_bf16(acc[2], acc[3]); o.z = cvt_pk_bf16(acc[4], acc[5]); o.w = cvt_pk_bf16(acc[6], acc[7]);
    *(LAS u32x4*)(tile + s * ML_LDQ + d8 * 2) = o;
}
__device__ __forceinline__ void phase_mlstm_local(Frame& F, const Args& args, const bf16_t* proj, const float* gates, bf16_t* U, float* nU, float* scal) {
    LAS unsigned char* kt = F.lds + RING_OFF;
    LAS unsigned char* vt = F.lds + RING_OFF + 64 * ML_LDQ;
    const int lane = F.lane, w = F.wave, tid = F.tid;
    const float* convw = ain(F, IN_MCONV);
    const float* igb = ain(F, IN_MIGB); const float* fgb = ain(F, IN_MFGB);
    constexpr int NIT = NB * 8 * 64;
    unsigned zz = 0u; asm volatile("" : "+v"(zz)); const u32x4 zero4 = (u32x4){zz, zz, zz, zz};
    u32x4 kx[4], vx[2]; float gi = 0.f, gf = 0.f;
    auto prefetch = [&](int item) {
        const int c = item & 63, h = (item >> 6) & 7, b = item >> 9;
        const int s = tid >> 3, d8 = (tid & 7) * 8;
#pragma unroll
        for (int j = 0; j < 4; ++j) { const int sp = 64 * c + s - 3 + j; kx[j] = zero4; if (sp >= 0) kx[j] = *(const u32x4*)(proj + ((size_t)b * SEQ + sp) * MLP + 512 + h * 64 + d8); }
#pragma unroll
        for (int i = 0; i < 2; ++i) { const int pc = tid + i * 512, sv = pc >> 4, dv8 = (pc & 15) * 8;
            vx[i] = *(const u32x4*)(proj + ((size_t)b * SEQ + 64 * c + sv) * MLP + 1024 + h * 128 + dv8); }
        const size_t t = (size_t)b * SEQ + 64 * c + lane;
        gi = gates[t * 16 + h]; gf = gates[t * 16 + 8 + h];
    };
    if (F.vcu < NIT) prefetch(F.vcu);
    for (int item = F.vcu; item < NIT; item += F.G) {
        const int h = (item >> 6) & 7;
        float bc, a, g;
        { const float ig = gi + igb[h]; float v = logsigmoidf_(gf + fgb[h]);
#pragma unroll
          for (int o = 1; o < 64; o <<= 1) { const float u = __shfl_up(v, o); if (lane >= o) v += u; }
          bc = v; a = ig - v; float m = a;
#pragma unroll
          for (int o = 1; o < 64; o <<= 1) { const float u = __shfl_up(m, o); if (lane >= o) m = fmaxf(m, u); }
          g = m; }
        const float g63 = __shfl(g, 63), bL = __shfl(bc, 63);
        __syncthreads();
        { const int s = tid >> 3, d8 = (tid & 7) * 8; const float ws_ = fexp(__shfl(a, s) - g63);
          ml_conv_piece_pre(kx, convw, s, 512 + h * 64, d8, ws_, kt); }
#pragma unroll
        for (int i = 0; i < 2; ++i) { const int pc = tid + i * 512, s = pc >> 4, d8 = (pc & 15) * 8; *(LAS u32x4*)(vt + s * ML_LDV + d8 * 2) = vx[i]; }
        __syncthreads();
        if (item + F.G < NIT) prefetch(item + F.G);
        const int mt = w & 3, nh = w >> 2, gq = lane >> 4;
        f32x4 acc[4];
#pragma unroll
        for (int n = 0; n < 4; ++n) acc[n] = (f32x4){0.f, 0.f, 0.f, 0.f};
#pragma unroll
        for (int ks = 0; ks < 2; ++ks) {
            const bf16x8 af = frag_tr(kt, ML_LDQ, 32 * ks + 8 * gq, 32 * ks + 8 * gq + 4, 16 * mt, lane);
#pragma unroll
            for (int n = 0; n < 4; ++n) { const bf16x8 bfr = frag_tr(vt, ML_LDV, 32 * ks + 8 * gq, 32 * ks + 8 * gq + 4, 16 * (4 * nh + n), lane);
                acc[n] = MFMA16(af, bfr, acc[n]); }
        }
        bf16_t* Ui = U + (size_t)item * 8192;
#pragma unroll
        for (int n = 0; n < 4; ++n)
#pragma unroll
            for (int r = 0; r < 4; ++r) Ui[(16 * mt + 4 * gq + r) * 128 + 16 * (4 * nh + n) + (lane & 15)] = (bf16_t)(cvt_pk_bf16(acc[n][r], 0.f) & 0xffffu);
        if (tid < 64) { float s8[8];
#pragma unroll
            for (int q = 0; q < 8; ++q) s8[q] = 0.f;
#pragma unroll
            for (int r = 0; r < 64; ++r) s8[r & 7] += bf2f(*(const LAS unsigned short*)(kt + r * ML_LDQ + tid * 2));
            nU[(size_t)item * 64 + tid] = ((s8[0] + s8[1]) + (s8[2] + s8[3])) + ((s8[4] + s8[5]) + (s8[6] + s8[7])); }
        if (tid == 0) { scal[item * 2] = bL; scal[item * 2 + 1] = bL + g63; }
    }
    __syncthreads();
}

__device__ __forceinline__ void phase_mlstm_scan(Frame& F, const bf16_t* U, const float* nU, const float* scal, bf16_t* Cst, float* nst, float* mst) {
    constexpr int GP = 1024 + 8;
    for (int gi = blockIdx.x * NTHREADS + F.tid; gi < 64 * GP; gi += F.G * NTHREADS) {
        const int chain = gi / GP, e = gi % GP; const bool isn = e >= 1024;
        f32x4 v0 = (f32x4){0.f, 0.f, 0.f, 0.f}, v1 = v0; float m = 0.f;
        for (int c0 = 0; c0 < 64; c0 += 8) {
            f32x4 u0[8], u1[8]; float bl[8], ml[8];
#pragma unroll
            for (int j = 0; j < 8; ++j) { const int item = chain * 64 + c0 + j;
                if (isn) { const float* src = nU + (size_t)item * 64 + (e - 1024) * 8; u0[j] = *(const f32x4*)src; u1[j] = *(const f32x4*)(src + 4); }
                else { const u32x4 r = *(const u32x4*)(U + (size_t)item * 8192 + e * 8);
                    u0[j] = (f32x4){bflo(r.x), bfhi(r.x), bflo(r.y), bfhi(r.y)}; u1[j] = (f32x4){bflo(r.z), bfhi(r.z), bflo(r.w), bfhi(r.w)}; }
                bl[j] = scal[item * 2]; ml[j] = scal[item * 2 + 1]; }
#pragma unroll
            for (int j = 0; j < 8; ++j) { const int item = chain * 64 + c0 + j;
                if (isn) { float* d = nst + (size_t)item * 64 + (e - 1024) * 8; *(f32x4*)d = v0; *(f32x4*)(d + 4) = v1; if (e == 1024) mst[item] = m; }
                else { u32x4 o; o.x = cvt_pk_bf16(v0[0], v0[1]); o.y = cvt_pk_bf16(v0[2], v0[3]); o.z = cvt_pk_bf16(v1[0], v1[1]); o.w = cvt_pk_bf16(v1[2], v1[3]);
                    *(u32x4*)(Cst + (size_t)item * 8192 + e * 8) = o; }
                const float mn = fmaxf(bl[j] + m, ml[j]);
                const float dec = fexp(bl[j] + m - mn), sc = fexp(ml[j] - mn);
                v0 = v0 * dec + u0[j] * sc; v1 = v1 * dec + u1[j] * sc; m = mn; }
        }
    }
}

__device__ __forceinline__ void phase_mlstm_out(Frame& F, const Args& args, const bf16_t* proj, const float* gates, const bf16_t* Cst, const float* nst, const float* mst, bf16_t* Out) {
    constexpr int CH_BYTES = 2 * 64 * ML_LDQ + 2 * 64 * ML_LDV + 256;
    const int lane = F.lane, w = F.wave, tid = F.tid;
    const float* convw = ain(F, IN_MCONV); const float* normg = ain(F, IN_MNORMG);
    const int half = w >> 2, wq = w & 3, gq = lane >> 4, tq = lane & 15;
    LAS unsigned char* base = F.lds + RING_OFF + half * CH_BYTES;
    LAS unsigned char* qt = base; LAS unsigned char* kt = base + 64 * ML_LDQ; LAS unsigned char* vt = base + 2 * 64 * ML_LDQ; LAS unsigned char* ct = vt + 64 * ML_LDV;
    LAS float* nl = (LAS float*)(ct + 64 * ML_LDV);
    for (int it2 = F.vcu; it2 < NB * 8 * 32; it2 += F.G) {
        const int cp = it2 & 31, h = (it2 >> 5) & 7, b = it2 >> 8;
        __syncthreads();
#pragma unroll
        for (int ib = 0; ib < 2; ++ib) {
            u32x4 cx[2][4];
#pragma unroll
            for (int i2 = 0; i2 < 2; ++i2) { const int i = 2 * ib + i2; const int pc = tid + i * 512, hf = pc >> 10, tens = (pc >> 9) & 1, r = pc & 511, s = r >> 3, d8 = (r & 7) * 8; const int c = 2 * cp + hf;
#pragma unroll
                for (int j = 0; j < 4; ++j) { const int sp = 64 * c + s - 3 + j; cx[i2][j] = (u32x4){0u, 0u, 0u, 0u};
                    if (sp >= 0) cx[i2][j] = *(const u32x4*)(proj + ((size_t)b * SEQ + sp) * MLP + tens * 512 + h * 64 + d8); } }
#pragma unroll
            for (int i2 = 0; i2 < 2; ++i2) { const int i = 2 * ib + i2; const int pc = tid + i * 512, hf = pc >> 10, tens = (pc >> 9) & 1, r = pc & 511, s = r >> 3, d8 = (r & 7) * 8;
                LAS unsigned char* tl = F.lds + RING_OFF + hf * CH_BYTES + tens * 64 * ML_LDQ;
                ml_conv_piece_pre(cx[i2], convw, s, tens * 512 + h * 64, d8, tens ? 1.0f : 0.125f, tl); }
        }
        {
            u32x4 vv[4], cc[4];
#pragma unroll
            for (int i = 0; i < 4; ++i) { const int pc = tid + i * 512, hf = pc >> 10, r = pc & 1023, s = r >> 4, d8 = (r & 15) * 8; const int c = 2 * cp + hf;
                vv[i] = *(const u32x4*)(proj + ((size_t)b * SEQ + 64 * c + s) * MLP + 1024 + h * 128 + d8);
                const int item = (b * 8 + h) * 64 + c;
                cc[i] = *(const u32x4*)(Cst + (size_t)item * 8192 + s * 128 + d8); }
#pragma unroll
            for (int i = 0; i < 4; ++i) { const int pc = tid + i * 512, hf = pc >> 10, r = pc & 1023, s = r >> 4, d8 = (r & 15) * 8;
                LAS unsigned char* vb = F.lds + RING_OFF + hf * CH_BYTES + 2 * 64 * ML_LDQ;
                *(LAS u32x4*)(vb + s * ML_LDV + d8 * 2) = vv[i]; *(LAS u32x4*)(vb + 64 * ML_LDV + s * ML_LDV + d8 * 2) = cc[i]; }
        }
        if (tid < 128) { const int hf = tid >> 6, c = 2 * cp + hf, item = (b * 8 + h) * 64 + c;
            ((LAS float*)(F.lds + RING_OFF + hf * CH_BYTES + 2 * 64 * ML_LDQ + 2 * 64 * ML_LDV))[tid & 63] = nst[(size_t)item * 64 + (tid & 63)]; }
        const int c = 2 * cp + half, item = (b * 8 + h) * 64 + c;
        float bc, a, g; ml_gate_scan(gates, ain(F, IN_MIGB), ain(F, IN_MFGB), b, h, c, lane, bc, a, g);
        const float mc = mst[item];
        const float mt_l = fmaxf(mc, g);
        const int tt = 16 * wq + tq;
        const float mt_t = __shfl(mt_l, tt), b_t = __shfl(bc, tt);
        const float winter = fexp(mc - mt_t);
        __syncthreads();
        const bf16x8 qf0 = frag_row(qt, ML_LDQ, 16 * wq, 0, lane), qf1 = frag_row(qt, ML_LDQ, 16 * wq, 32, lane);
        f32x4 P[4]; float rs = 0.f;
#pragma unroll
        for (int kt_ = 0; kt_ < 4; ++kt_) {
            f32x4 s4 = (f32x4){0.f, 0.f, 0.f, 0.f};
            if (kt_ <= wq) {
                s4 = MFMA16(frag_row(kt, ML_LDQ, 16 * kt_, 0, lane), qf0, s4);
                s4 = MFMA16(frag_row(kt, ML_LDQ, 16 * kt_, 32, lane), qf1, s4);
            }
#pragma unroll
            for (int r = 0; r < 4; ++r) { const int s = 16 * kt_ + 4 * gq + r; const float as = __shfl(a, s);
                const float p = (s <= tt && kt_ <= wq) ? s4[r] * fexp(as - mt_t) : 0.f; P[kt_][r] = p; rs += p; }
        }
        rs += __shfl_xor(rs, 16); rs += __shfl_xor(rs, 32);
        float qn = 0.f;
#pragma unroll
        for (int i = 0; i < 16; ++i) { const int dk = 16 * gq + i; qn += bf2f(*(const LAS unsigned short*)(qt + tt * ML_LDQ + dk * 2)) * nl[dk]; }
        qn += __shfl_xor(qn, 16); qn += __shfl_xor(qn, 32);
        const float den = winter * qn + rs;
        const float dnm = fmaxf(fabsf(den), fexp(-(b_t + mt_t)));
        const float inv = fast_rcp(dnm);
        f32x4 acc[8];
#pragma unroll
        for (int n = 0; n < 8; ++n) { f32x4 z = (f32x4){0.f, 0.f, 0.f, 0.f};
            z = MFMA16(frag_tr(ct, ML_LDV, 8 * gq, 8 * gq + 4, 16 * n, lane), qf0, z);
            z = MFMA16(frag_tr(ct, ML_LDV, 32 + 8 * gq, 32 + 8 * gq + 4, 16 * n, lane), qf1, z);
            acc[n] = z * winter; }
#pragma unroll
        for (int pr = 0; pr < 2; ++pr) {
            if (2 * pr <= wq) {
                const bf16x8 pf = pack_bf16x8(P[2 * pr], P[2 * pr + 1]);
#pragma unroll
                for (int n = 0; n < 8; ++n) acc[n] = MFMA16(frag_tr(vt, ML_LDV, 32 * pr + 4 * gq, 32 * pr + 16 + 4 * gq, 16 * n, lane), pf, acc[n]);
            }
        }
        float sm = 0.f;
#pragma unroll
        for (int n = 0; n < 8; ++n) { acc[n] = acc[n] * inv; sm += (acc[n][0] + acc[n][1]) + (acc[n][2] + acc[n][3]); }
        sm += __shfl_xor(sm, 16); sm += __shfl_xor(sm, 32);
        const float mu = sm * (1.0f / 128.0f); float sq = 0.f;
#pragma unroll
        for (int n = 0; n < 8; ++n) { acc[n] = acc[n] - mu; sq += (acc[n][0] * acc[n][0] + acc[n][1] * acc[n][1]) + (acc[n][2] * acc[n][2] + acc[n][3] * acc[n][3]); }
        sq += __shfl_xor(sq, 16); sq += __shfl_xor(sq, 32);
        const float rstd = frsq(sq * (1.0f / 128.0f) + LN_EPS);
        const size_t trow = (size_t)b * SEQ + 64 * c + tt;
#pragma unroll
        for (int n = 0; n < 8; ++n) { const int dv = 16 * n + 4 * gq;
            const u32x2 ow = *(const u32x2*)(proj + trow * MLP + 2048 + h * 128 + dv); const f32x4 ng = *(const f32x4*)(normg + h * 128 + dv);
            const float o0 = acc[n][0] * rstd * ng[0] * sigmoidf_(bflo(ow.x)), o1 = acc[n][1] * rstd * ng[1] * sigmoidf_(bfhi(ow.x));
            const float o2 = acc[n][2] * rstd * ng[2] * sigmoidf_(bflo(ow.y)), o3 = acc[n][3] * rstd * ng[3] * sigmoidf_(bfhi(ow.y));
            u32x2 st; st.x = cvt_pk_bf16(o0, o1); st.y = cvt_pk_bf16(o2, o3);
            *(u32x2*)(Out + trow * D + h * 128 + dv) = st; }
    }
    __syncthreads();
}

constexpr int NSP = 2560, NS_LD = 144;
__device__ __forceinline__ void phase_nsa_compress(Frame& F, const bf16_t* proj, const bf16_t* WtK, const bf16_t* WtV, const float* cbias, const float* rc, const float* rs, bf16_t* KC, bf16_t* VC) {
    const int lane = F.lane, gq = lane >> 4, tq = lane & 15;
    const int gw = F.vcu * NWAVES + F.wave, NGW = F.G * NWAVES;
    for (int item = gw; item < NB * 4 * 16 * 2; item += NGW) {
        const int which = item & 1, ct = (item >> 1) & 15, g = (item >> 5) & 3, b = item >> 7;
        const bf16_t* Wt = which ? WtV : WtK;
        const int c_m = 16 * ct + tq;
        const bf16_t* arow = proj + ((size_t)b * SEQ + 16 * c_m) * NSP + (which ? 1280 : 1024) + g * 64 + 8 * gq;
        f32x4 acc[4];
#pragma unroll
        for (int n = 0; n < 4; ++n) acc[n] = (f32x4){0.f, 0.f, 0.f, 0.f};
#pragma unroll 4
        for (int ks = 0; ks < 64; ++ks) {
            const int l = ks >> 1, d0 = (ks & 1) * 32;
            bf16x8 af = (bf16x8){0, 0, 0, 0, 0, 0, 0, 0};
            if (16 * c_m + l < SEQ) af = *(const bf16x8*)(arow + (size_t)l * NSP + d0);
#pragma unroll
            for (int n = 0; n < 4; ++n) { const bf16x8 bfr = *(const bf16x8*)(Wt + (size_t)(16 * n + tq) * 2048 + 32 * ks + 8 * gq); acc[n] = MFMA16(af, bfr, acc[n]); }
        }
        const float b0 = cbias[which * 64 + tq], b1 = cbias[which * 64 + 16 + tq], b2 = cbias[which * 64 + 32 + tq], b3 = cbias[which * 64 + 48 + tq];
#pragma unroll
        for (int r = 0; r < 4; ++r) {
            const int c = 16 * ct + 4 * gq + r;
            const float x0 = acc[0][r] + b0, x1 = acc[1][r] + b1, x2 = acc[2][r] + b2, x3 = acc[3][r] + b3;
            bf16_t* dst = (which ? VC : KC) + (((size_t)b * 256 + c) * 4 + g) * 64;
            if (which) { dst[tq] = (bf16_t)f2bf(x0); dst[16 + tq] = (bf16_t)f2bf(x1); dst[32 + tq] = (bf16_t)f2bf(x2); dst[48 + tq] = (bf16_t)f2bf(x3); }
            else {
                const int pos = (16 * c + 31) & (SEQ - 1);
                const float c0 = rc[pos * 32 + tq], s0 = rs[pos * 32 + tq], c1 = rc[pos * 32 + 16 + tq], s1 = rs[pos * 32 + 16 + tq];
                const float y0 = x0 * c0 - x2 * s0, y2 = x0 * s0 + x2 * c0, y1 = x1 * c1 - x3 * s1, y3 = x1 * s1 + x3 * c1;
                dst[rope_phi(tq)] = (bf16_t)f2bf(y0); dst[rope_phi(16 + tq)] = (bf16_t)f2bf(y1); dst[rope_phi(32 + tq)] = (bf16_t)f2bf(y2); dst[rope_phi(48 + tq)] = (bf16_t)f2bf(y3);
            }
        }
    }
}

constexpr int NH = 2;
template <int MODE, int MK, class MaskF>
__device__ __forceinline__ void nsa_sub(const LAS unsigned char* kt, const LAS unsigned char* vt, int j0, int lane, const bf16x8 (&qf)[NH][2], const MaskF& valid, bool lanev,
                                        float (&m)[NH], float (&l)[NH], f32x4 (&acc)[NH][4], float (&psa)[4], float (&psb)[4]) {
    const int gq = lane >> 4;
    bf16x8 kf[2][2];
#pragma unroll
    for (int h2 = 0; h2 < 2; ++h2) { kf[h2][0] = frag_row(kt, NS_LD, j0 + 16 * h2, 0, lane); kf[h2][1] = frag_row(kt, NS_LD, j0 + 16 * h2, 32, lane); }
    bf16x8 vf[4];
    if (MODE != 0) frag_tr4<NS_LD>(vt, j0 + 4 * gq, lane, vf);
    bool ok[2][4];
    if (MK == 1) {
#pragma unroll
        for (int h2 = 0; h2 < 2; ++h2)
#pragma unroll
            for (int r = 0; r < 4; ++r) ok[h2][r] = valid(j0 + 16 * h2 + 4 * gq + r);
    }
#pragma unroll
    for (int jh = 0; jh < NH; ++jh) {
        f32x4 s[2];
#pragma unroll
        for (int h2 = 0; h2 < 2; ++h2) { f32x4 z = (f32x4){0.f, 0.f, 0.f, 0.f}; z = MFMA16(kf[h2][0], qf[jh][0], z); z = MFMA16(kf[h2][1], qf[jh][1], z); s[h2] = z; }
        if (MODE == 1) {
#pragma unroll
            for (int h2 = 0; h2 < 2; ++h2)
#pragma unroll
                for (int r = 0; r < 4; ++r) { const float p = ok[h2][r] ? fast_exp2(s[h2][r] * SM_C - m[jh]) * l[jh] : 0.f; s[h2][r] = p; }
#pragma unroll
            for (int r = 0; r < 4; ++r) { psa[r] += s[0][r]; psb[r] += s[1][r]; }
            const bf16x8 pf = pack_bf16x8(s[0], s[1]);
#pragma unroll
            for (int n = 0; n < 4; ++n) acc[jh][n] = MFMA16(vf[n], pf, acc[jh][n]);
        } else {
            if (MK == 1) {
#pragma unroll
                for (int h2 = 0; h2 < 2; ++h2)
#pragma unroll
                    for (int r = 0; r < 4; ++r) s[h2][r] = ok[h2][r] ? s[h2][r] : -3.0e38f;
            }
            float mx8 = fmaxf(fmaxf(fmaxf(s[0][0], s[0][1]), fmaxf(s[0][2], s[0][3])), fmaxf(fmaxf(s[1][0], s[1][1]), fmaxf(s[1][2], s[1][3])));
            const bool lv = (MK == 1) ? true : lanev;
            if (__any(lv && (mx8 * SM_C > m[jh] + 8.0f))) {
                float mx = lv ? mx8 * SM_C : NEG_BIG; mx = fmaxf(mx, NEG_BIG);
                mx = fmaxf(mx, __shfl_xor(mx, 16)); mx = fmaxf(mx, __shfl_xor(mx, 32));
                const float mnew = fmaxf(m[jh], mx), alpha = fast_exp2(m[jh] - mnew);
                l[jh] *= alpha; m[jh] = mnew;
                if (MODE == 2) {
#pragma unroll
                    for (int n = 0; n < 4; ++n) acc[jh][n] = acc[jh][n] * alpha;
                }
            }
            const float negm = lv ? -m[jh] : -3.0e38f;
            float ps = 0.f;
#pragma unroll
            for (int h2 = 0; h2 < 2; ++h2)
#pragma unroll
                for (int r = 0; r < 4; ++r) { const float pe = fast_exp2(__builtin_fmaf(s[h2][r], SM_C, negm)); s[h2][r] = pe; ps += pe; }
            l[jh] += ps;
            if (MODE == 2) {
                const bf16x8 pf = pack_bf16x8(s[0], s[1]);
#pragma unroll
                for (int n = 0; n < 4; ++n) acc[jh][n] = MFMA16(vf[n], pf, acc[jh][n]);
            }
        }
    }
}
__device__ __forceinline__ void nsa_blk64(const LAS unsigned char* KH, const LAS unsigned char* VH, int lane, const bf16x8 (&qf)[NH][2], int key0, int klo, int khi, bool lanev, bool full,
                                          float (&m)[NH], float (&l)[NH], f32x4 (&acc)[NH][4]) {
    const int gq = lane >> 4;
    f32x4 s[2][NH][2];
#pragma unroll
    for (int hf = 0; hf < 2; ++hf) {
        bf16x8 kf[2][2];
#pragma unroll
        for (int h2 = 0; h2 < 2; ++h2) { kf[h2][0] = frag_row(KH, NS_LD, 32 * hf + 16 * h2, 0, lane); kf[h2][1] = frag_row(KH, NS_LD, 32 * hf + 16 * h2, 32, lane); }
#pragma unroll
        for (int jh = 0; jh < NH; ++jh)
#pragma unroll
            for (int h2 = 0; h2 < 2; ++h2) { f32x4 z = (f32x4){0.f, 0.f, 0.f, 0.f}; z = MFMA16(kf[h2][0], qf[jh][0], z); z = MFMA16(kf[h2][1], qf[jh][1], z); s[hf][jh][h2] = z; }
    }
    if (!full) {
#pragma unroll
        for (int hf = 0; hf < 2; ++hf)
#pragma unroll
            for (int h2 = 0; h2 < 2; ++h2)
#pragma unroll
                for (int r = 0; r < 4; ++r) { const int key = key0 + 32 * hf + 16 * h2 + 4 * gq + r; const bool ok = (key >= klo) && (key <= khi);
#pragma unroll
                    for (int jh = 0; jh < NH; ++jh) s[hf][jh][h2][r] = ok ? s[hf][jh][h2][r] : -3.0e38f; }
    }
    const bool lv = lanev;
    float negm[NH];
#pragma unroll
    for (int jh = 0; jh < NH; ++jh) {
        float mx = NEG_BIG;
#pragma unroll
        for (int hf = 0; hf < 2; ++hf)
#pragma unroll
            for (int h2 = 0; h2 < 2; ++h2) mx = fmaxf(mx, fmaxf(fmaxf(s[hf][jh][h2][0], s[hf][jh][h2][1]), fmaxf(s[hf][jh][h2][2], s[hf][jh][h2][3])));
        mx = lv ? mx * SM_C : NEG_BIG; mx = fmaxf(mx, NEG_BIG);
        if (__any(mx > m[jh] + 8.0f)) {
            mx = fmaxf(mx, __shfl_xor(mx, 16)); mx = fmaxf(mx, __shfl_xor(mx, 32));
            const float mnew = fmaxf(m[jh], mx), alpha = fast_exp2(m[jh] - mnew);
            l[jh] *= alpha; m[jh] = mnew;
#pragma unroll
            for (int n = 0; n < 4; ++n) acc[jh][n] = acc[jh][n] * alpha;
        }
        negm[jh] = lv ? -m[jh] : -3.0e38f;
    }
#pragma unroll
    for (int hf = 0; hf < 2; ++hf) {
        bf16x8 vf[4]; frag_tr4<NS_LD>(VH, 32 * hf + 4 * gq, lane, vf);
#pragma unroll
        for (int jh = 0; jh < NH; ++jh) {
            float ps = 0.f;
#pragma unroll
            for (int h2 = 0; h2 < 2; ++h2)
#pragma unroll
                for (int r = 0; r < 4; ++r) { const float pe = fast_exp2(__builtin_fmaf(s[hf][jh][h2][r], SM_C, negm[jh])); s[hf][jh][h2][r] = pe; ps += pe; }
            l[jh] += ps;
            const bf16x8 pf = pack_bf16x8(s[hf][jh][0], s[hf][jh][1]);
#pragma unroll
            for (int n = 0; n < 4; ++n) acc[jh][n] = MFMA16(vf[n], pf, acc[jh][n]);
        }
    }
}
__device__ __forceinline__ void nsa_flush(u32x2 (&fin)[NH][4], unsigned char* Out8, size_t tok, int hbase, int lane, const float (&gpre)[NH][3], int branch, const f32x4 (&acc)[NH][4], const float (&sc)[NH], bool first) {
    const int gq = lane >> 4;
#pragma unroll
    for (int jh = 0; jh < NH; ++jh) {
        const float gt = sigmoidf_(branch == 0 ? gpre[jh][0] : (branch == 1 ? gpre[jh][1] : gpre[jh][2])) * sc[jh];
#pragma unroll
        for (int n = 0; n < 4; ++n) {
            float o0 = acc[jh][n][0] * gt, o1 = acc[jh][n][1] * gt, o2 = acc[jh][n][2] * gt, o3 = acc[jh][n][3] * gt;
            if (!first) { const u32x2 w = fin[jh][n]; o0 += bflo(w.x); o1 += bfhi(w.x); o2 += bflo(w.y); o3 += bfhi(w.y); }
            if (branch == 2) *(unsigned*)(Out8 + tok * D + (hbase + jh) * 64 + 16 * n + 4 * gq) = pk4_fp8(o0, o1, o2, o3);
            else { fin[jh][n].x = cvt_pk_bf16(o0, o1); fin[jh][n].y = cvt_pk_bf16(o2, o3); }
        }
    }
}

__device__ __forceinline__ void phase_nsa_attn(Frame& F, const bf16_t* proj, const float* gates, const bf16_t* KC, const bf16_t* VC, bf16_t* Out, unsigned char* Out8) {
    constexpr int OFF_KC = 0, OFF_VC = 256 * NS_LD, OFF_IMP = 2 * 256 * NS_LD, BUFB = 2 * 128 * NS_LD;
    const int lane = F.lane, w = F.wave, tid = F.tid, gq = lane >> 4, tq = lane & 15;
    LAS unsigned char* L = F.lds + RING_OFF;
    LAS float* impl = (LAS float*)(L + OFF_IMP) + w * 1024 + tq * 64;
    LAS float* impo = (LAS float*)(L + OFF_IMP) + (w ^ 4) * 1024 + tq * 64;
    const int nitems = NB * 4 * 64, nrounds = (nitems + F.G - 1) / F.G;
    for (int k = 0; k < nrounds; ++k) {
        const int item = F.vcu + k * F.G; if (item >= nitems) break;
        const int jr = item & 63, g = (item >> 6) & 3, b = item >> 8;
        const int jt = (k & 1) ? 63 - jr : jr;
        const int t0 = 64 * jt, tw = t0 + 16 * (w & 3), tme = tw + tq;
        const size_t tok = (size_t)b * SEQ + tme;
        const bf16_t* pb = proj + (size_t)b * SEQ * NSP;
        const int hbase = 4 * g + 2 * (w >> 2), qblk = jt;
        bf16x8 qf[NH][2];
#pragma unroll
        for (int jh = 0; jh < NH; ++jh) { qf[jh][0] = *(const bf16x8*)(proj + tok * NSP + (hbase + jh) * 64 + 8 * gq); qf[jh][1] = *(const bf16x8*)(proj + tok * NSP + (hbase + jh) * 64 + 32 + 8 * gq); }
        float gpre[NH][3];
#pragma unroll
        for (int jh = 0; jh < NH; ++jh)
#pragma unroll
            for (int br3 = 0; br3 < 3; ++br3) gpre[jh][br3] = gates[tok * 48 + (hbase + jh) * 3 + br3];
        float m[NH], l[NH], psa[4], psb[4]; f32x4 acc[NH][4];
        const int ncv = (t0 + 63 >= 31) ? ((t0 + 63 - 31) >> 4) + 1 : 0;
        const int ncb = (ncv + 31) >> 5;
        __syncthreads();
        for (int pc = tid; pc < ncb * 32 * 8 * 2; pc += NTHREADS) { const int tn = pc & 1, rr = pc >> 1, c = rr >> 3, d8 = (rr & 7) * 8;
            *(LAS u32x4*)(L + (tn ? OFF_VC : OFF_KC) + c * NS_LD + d8 * 2) = *(const u32x4*)((tn ? VC : KC) + (((size_t)b * 256 + c) * 4 + g) * 64 + d8); }
#pragma unroll
        for (int i = 0; i < 16; ++i) impl[4 * i + gq] = 0.f;
        __syncthreads();
        auto vcmp = [&](int c) { return 16 * c + 31 <= tme; };
#pragma unroll
        for (int jh = 0; jh < NH; ++jh) { m[jh] = NEG_BIG; l[jh] = 0.f; }
        const int ncw = (tw + 15 >= 31) ? ((((tw + 15 - 31) >> 4) + 1 + 31) >> 5) : 0;
#pragma clang loop unroll(disable)
        for (int kb = 0; kb < ncw; ++kb) nsa_sub<0, 1>(L + OFF_KC, L + OFF_VC, 32 * kb, lane, qf, vcmp, true, m, l, acc, psa, psb);
#pragma unroll
        for (int jh = 0; jh < NH; ++jh) { float lt = l[jh]; lt += __shfl_xor(lt, 16); lt += __shfl_xor(lt, 32); l[jh] = lt > 0.f ? fast_rcp(lt) : 0.f;
#pragma unroll
            for (int n = 0; n < 4; ++n) acc[jh][n] = (f32x4){0.f, 0.f, 0.f, 0.f}; }
        float prevb3 = 0.f;
#pragma clang loop unroll(disable)
        for (int kb = 0; kb < ncw; ++kb) {
#pragma unroll
            for (int r = 0; r < 4; ++r) { psa[r] = 0.f; psb[r] = 0.f; }
            nsa_sub<1, 1>(L + OFF_KC, L + OFF_VC, 32 * kb, lane, qf, vcmp, true, m, l, acc, psa, psb);
            const float upa_hi = __shfl(psa[3], (lane + 48) & 63), upa_lo = __shfl(prevb3, (lane + 48) & 63);
            const float upb_hi = __shfl(psb[3], (lane + 48) & 63);
            const float ea = (gq >= 1) ? upa_hi : upa_lo;
            const float eb = (gq >= 1) ? upb_hi : upa_hi;
            impl[8 * kb + gq] = (psa[0] + psa[1]) + (psa[2] + psa[3]) + ea;
            impl[8 * kb + 4 + gq] = (psb[0] + psb[1]) + (psb[2] + psb[3]) + eb;
            prevb3 = psb[3];
        }
        u32x2 fin[NH][4];
        { const float one[NH] = {1.f, 1.f}; nsa_flush(fin, Out8, tok, hbase, lane, gpre, 0, acc, one, true); }
        __syncthreads();
        const int sj = (tid & 511) >> 3, sd8 = (tid & 7) * 8;
        const bf16_t* srow = pb + (size_t)sj * NSP + g * 64 + sd8;
        u32x4 pre[4];
        auto ldstage = [&](int kc, int st_) {
#pragma unroll
            for (int i = 0; i < 4; ++i) pre[i] = *(const u32x4*)(srow + (size_t)(128 * st_ + 64 * (i & 1)) * NSP + kc + ((i >> 1) ? 256 : 0)); };
        ldstage(1536, 0);
        const int nlo_w = (t0 - 511 > 0) ? ((t0 - 511) >> 6) : 0;
        unsigned long long selmask;
        if (qblk < 16) selmask = (2ull << qblk) - 1ull;
        else {
            unsigned pk[16];
#pragma unroll
            for (int i = 0; i < 16; ++i) { const int n = 4 * i + gq; const bool forced = (n == 0) || (n == qblk) || (n == qblk - 1);
                const float v = forced ? 1.0e4f : (impl[n] + impo[n]) + 1.0f;
                pk[i] = (n > qblk) ? 0u : ((__float_as_uint(v) & ~63u) | (unsigned)(63 - n)); }
            selmask = 0ull;
#pragma clang loop unroll(disable)
            for (int it = 0; it < 16; ++it) {
                unsigned cur = pk[0];
#pragma unroll
                for (int i = 1; i < 16; ++i) cur = cur > pk[i] ? cur : pk[i];
                { const unsigned o = (unsigned)__shfl_xor((int)cur, 16); cur = cur > o ? cur : o; }
                { const unsigned o = (unsigned)__shfl_xor((int)cur, 32); cur = cur > o ? cur : o; }
                if (cur != 0u) selmask |= 1ull << (63 - (cur & 63u));
#pragma unroll
                for (int i = 0; i < 16; ++i) pk[i] = (pk[i] == cur) ? 0u : pk[i];
            }
        }
#pragma unroll 1
        for (int br = 1; br <= 2; ++br) {
            const int nlo = (br == 1) ? 0 : nlo_w;
            const int kcol = (br == 1) ? 1536 : 2048, vcol = kcol + 256;
#pragma unroll
            for (int jh = 0; jh < NH; ++jh) { m[jh] = NEG_BIG; l[jh] = 0.f;
#pragma unroll
                for (int n = 0; n < 4; ++n) acc[jh][n] = (f32x4){0.f, 0.f, 0.f, 0.f}; }
            const int s_lo = nlo >> 1, s_hi = qblk >> 1;
            int bf = 0;
            __syncthreads();
#pragma clang loop unroll(disable)
            for (int st = s_lo; st <= s_hi; ++st) {
                LAS unsigned char* KB = L + bf * BUFB; LAS unsigned char* VB = KB + 128 * NS_LD;
#pragma unroll
                for (int i = 0; i < 4; ++i) *(LAS u32x4*)(((i >> 1) ? VB : KB) + (sj + 64 * (i & 1)) * NS_LD + sd8 * 2) = pre[i];
                __syncthreads();
                if (st < s_hi) {
#pragma unroll
                    for (int i = 0; i < 4; ++i) pre[i] = *(const u32x4*)(srow + (size_t)(128 * (st + 1) + 64 * (i & 1)) * NSP + ((i >> 1) ? vcol : kcol)); }
#pragma clang loop unroll(disable)
                for (int hb = 0; hb < 2; ++hb) {
                    const int nb = 2 * st + hb;
                    if (nb < nlo || nb > qblk) continue;
                    const LAS unsigned char* KH = KB + hb * 64 * NS_LD; const LAS unsigned char* VH = VB + hb * 64 * NS_LD;
                    bool lanev = true, full; int klo = 0;
                    if (br == 1) { lanev = (selmask >> nb) & 1ull; if (__ballot(lanev) == 0ull) continue; full = nb < qblk; }
                    else { if (64 * nb + 63 < tw - 511) continue; klo = tme - 511; full = (64 * nb >= tw + 15 - 511) && (64 * nb + 63 <= tw); }
                    nsa_blk64(KH, VH, lane, qf, 64 * nb, klo, tme, lanev, full, m, l, acc);
                }
                bf ^= 1;
            }
            if (br == 1) ldstage(2048, nlo_w >> 1);
            float sc[NH];
#pragma unroll
            for (int jh = 0; jh < NH; ++jh) { float lt = l[jh]; lt += __shfl_xor(lt, 16); lt += __shfl_xor(lt, 32); sc[jh] = lt > 0.f ? fast_rcp(lt) : 0.f; }
            nsa_flush(fin, Out8, tok, hbase, lane, gpre, br, acc, sc, false);
        }
    }
    __syncthreads();
}


__device__ __forceinline__ void phase_pool_diff(Frame& F, const bf16_t* X, bf16_t* Dst) {
    const int gw = F.vcu * NWAVES + F.wave, NGW = F.G * NWAVES, lane = F.lane;
    constexpr int RUN = 16, NRUN = SEQ / RUN;
    for (int item = gw; item < NB * NRUN * 4; item += NGW) {
        const int grp = item & 3, run = (item >> 2) % NRUN, b = item / (4 * NRUN);
        const int w = 2 << grp, s0 = run * RUN, col = grp * 256 + 4 * lane;
        const bf16_t* xb = X + ((size_t)b * SEQ) * D + col;
        u32x2 raw[RUN + 15];
#pragma unroll
        for (int r = 0; r < RUN + 15; ++r) { const int s = s0 - 15 + r; raw[r] = (u32x2){0u, 0u}; if (s >= 0 && r >= 16 - w) raw[r] = *(const u32x2*)(xb + (size_t)s * D); }
        f32x4 sum = (f32x4){0.f, 0.f, 0.f, 0.f};
#pragma unroll
        for (int r = 0; r < 15; ++r) if (r >= 16 - w) sum += (f32x4){bflo(raw[r].x), bfhi(raw[r].x), bflo(raw[r].y), bfhi(raw[r].y)};
#pragma unroll
        for (int i = 0; i < RUN; ++i) {
            const int s = s0 + i;
            const f32x4 xv = (f32x4){bflo(raw[15 + i].x), bfhi(raw[15 + i].x), bflo(raw[15 + i].y), bfhi(raw[15 + i].y)};
            sum += xv;
            const float inv = fast_rcp((float)((s + 1 < w) ? (s + 1) : w));
            const f32x4 dv = sum * inv - xv;
            u32x2 o; o.x = cvt_pk_bf16(dv[0], dv[1]); o.y = cvt_pk_bf16(dv[2], dv[3]);
            *(u32x2*)(Dst + ((size_t)b * SEQ + s) * D + col) = o;
#pragma unroll
            for (int k = 1; k <= 4; ++k) if (w == (1 << k)) { const u32x2 rr = raw[15 + i - (1 << k) + 1]; sum -= (f32x4){bflo(rr.x), bfhi(rr.x), bflo(rr.y), bfhi(rr.y)}; }
        }
    }
}

#define HAVE_MIXER(l) true
__host__ __device__ inline bool phase_used_lk(int l, int k) {
    if (k == 14) return false;
    if (k == 0 || k >= 7) return true;
    if (l == 3) return k == 2 || k == 6;
    if (l == 0) return k == 1 || k == 2 || k == 3 || k == 4 || k == 6;
    if (l == 2) return k == 1 || k == 2 || k == 3 || k == 6;
    if (l == 1) return k == 1 || k == 2 || k == 3 || k == 6;
    return false;
}
__host__ __device__ inline bool phase_used(int ph) { return phase_used_lk(ph / 16, ph % 16); }
#ifndef MIX_ONLY
#define MIX_ONLY -1
#endif
#define MIXL(x) (MIX_ONLY < 0 || MIX_ONLY == (x))
#ifndef ONE_LAUNCH
#define ONE_LAUNCH 1
#endif
#define ML_U   (ws + WS_R1 + 192 * MiB)
#define ML_CST (ws + WS_R1 + 320 * MiB)
#define ML_NU  (ws + WS_MSC)
#define ML_NST (ws + WS_MSC + 1 * MiB)
#define ML_SCAL (ws + WS_MSC + 2 * MiB)
#define ML_MST (ws + WS_MSC + 2 * MiB + 512 * 1024)
__device__ __forceinline__ unsigned char* flatp(GAS unsigned char* p) { unsigned char* q = (unsigned char*)p; asm volatile("" : "+s"(q)); return q; }
#define MIXER_PHASES \
        if (MIXL(0) && l == 0) { \
            if (IN(PH_MIX_IN)) for (int rep_ = 0; rep_ < NREP(PH_MIX_IN); ++rep_) { \
                pg8::Gemm g{xb_in, (const bf16_t*)(wb + W_MIXIN), D, D, D}; pg8::SchedPlain S; S.init(T, 3328, F.G, (int)blockIdx.x, D, D, 0); \
                EpiProj E{(bf16_t*)(ws + WS_R1), 3072, 0, (float*)(ws + WS_AUX), 16, 12, nullptr, nullptr, nullptr}; \
                pg8::gemm_phase<EpiProj, pg8::SchedPlain, false, false>(F.lds + RING_OFF, g, S, E); \
                SEAM(PH_MIX_IN); } \
            if (IN(PH_MIX_A)) for (int rep_ = 0; rep_ < NREP(PH_MIX_A); ++rep_) { phase_mlstm_local(F, args, (const bf16_t*)(ws + WS_R1), (const float*)(ws + WS_AUX), (bf16_t*)ML_U, (float*)ML_NU, (float*)ML_SCAL); SEAM(PH_MIX_A); } \
            if (IN(PH_MIX_B)) for (int rep_ = 0; rep_ < NREP(PH_MIX_B); ++rep_) { phase_mlstm_scan(F, (const bf16_t*)ML_U, (const float*)ML_NU, (const float*)ML_SCAL, (bf16_t*)ML_CST, (float*)ML_NST, (float*)ML_MST); SEAM(PH_MIX_B); } \
            if (IN(PH_MIX_C)) for (int rep_ = 0; rep_ < NREP(PH_MIX_C); ++rep_) { phase_mlstm_out(F, args, (const bf16_t*)(ws + WS_R1), (const float*)(ws + WS_AUX), (const bf16_t*)ML_CST, (const float*)ML_NST, (const float*)ML_MST, (bf16_t*)(ws + WS_R2)); SEAM(PH_MIX_C); } \
            if (IN(PH_MIX_OUT)) for (int rep_ = 0; rep_ < NREP(PH_MIX_OUT); ++rep_) { \
                pg8::Gemm g{(const bf16_t*)(ws + WS_R2), (const bf16_t*)(wb + W_MIXOUT), D, D, D}; pg8::SchedPlain S; S.init(T, D, F.G, (int)blockIdx.x, D, D, 0); \
                EpiBf16 E{nullptr, D, nullptr, (unsigned char*)(ws + WS_R1)}; \
                pg8::gemm_phase<EpiBf16, pg8::SchedPlain, false, false>(F.lds + RING_OFF, g, S, E); \
                SEAM(PH_MIX_OUT); } \
        } \
        if (MIXL(1) && l == 1) { \
            if (IN(PH_MIX_IN)) for (int rep_ = 0; rep_ < NREP(PH_MIX_IN); ++rep_) { \
                pg8::Gemm g{(const bf16_t*)x8_in, (const bf16_t*)(wb + W_MIXIN), D / 2, D / 2, D / 2}; pg8::SchedPlain S; S.init(T, 2816, F.G, (int)blockIdx.x, D / 2, D / 2, 0); \
                EpiProj E{(bf16_t*)(ws + WS_R1), 2560, 1, (float*)(ws + WS_AUX), 48, 10, (const float*)(ws + WS_ROPE), (const float*)(ws + WS_ROPE) + SEQ * 32, nullptr}; \
                pg8::gemm_phase<EpiProj, pg8::SchedPlain, false, true>(F.lds + RING_OFF, g, S, E); \
                SEAM(PH_MIX_IN); } \
            if (IN(PH_MIX_A)) for (int rep_ = 0; rep_ < NREP(PH_MIX_A); ++rep_) { phase_nsa_compress(F, (const bf16_t*)(ws + WS_R1), (const bf16_t*)(wb + W_CMPK), (const bf16_t*)(wb + W_CMPV), (const float*)(wb + W_CMPB), \
                (const float*)(ws + WS_ROPE), (const float*)(ws + WS_ROPE) + SEQ * 32, (bf16_t*)(ws + WS_R1 + 160 * MiB), (bf16_t*)(ws + WS_R1 + 161 * MiB)); SEAM(PH_MIX_A); } \
            if (IN(PH_MIX_B)) for (int rep_ = 0; rep_ < NREP(PH_MIX_B); ++rep_) { phase_nsa_attn(F, (const bf16_t*)flatp(ws + WS_R1), (const float*)flatp(ws + WS_AUX), (const bf16_t*)flatp(ws + WS_R1 + 160 * MiB), (const bf16_t*)flatp(ws + WS_R1 + 161 * MiB), (bf16_t*)flatp(ws + WS_R2), (unsigned char*)flatp(ws + WS_R2 + 64 * MiB)); SEAM(PH_MIX_B); } \
            if (IN(PH_MIX_OUT)) for (int rep_ = 0; rep_ < NREP(PH_MIX_OUT); ++rep_) { \
                pg8::Gemm g{(const bf16_t*)(ws + WS_R2 + 64 * MiB), (const bf16_t*)(wb + W_MIXOUT), D / 2, D / 2, D / 2}; pg8::SchedPlain S; S.init(T, D, F.G, (int)blockIdx.x, D / 2, D / 2, 0); \
                EpiBf16 E{nullptr, D, nullptr, (unsigned char*)(ws + WS_R1)}; \
                pg8::gemm_phase<EpiBf16, pg8::SchedPlain, false, true>(F.lds + RING_OFF, g, S, E); \
                SEAM(PH_MIX_OUT); } \
        } \
        if (MIXL(2) && l == 2) { \
            if (IN(PH_MIX_IN)) for (int rep_ = 0; rep_ < NREP(PH_MIX_IN); ++rep_) { \
                pg8::Gemm g{(const bf16_t*)x8_in, (const bf16_t*)(wb + W_MIXIN), D / 2, D / 2, D / 2}; pg8::SchedPlain S; S.init(T, 7168, F.G, (int)blockIdx.x, D / 2, D / 2, 0); \
                EpiProj E{(bf16_t*)(ws + WS_R1), 7168, 2, nullptr, 0, -1, (const float*)(ws + WS_ROPE), (const float*)(ws + WS_ROPE) + SEQ * 32, (unsigned char*)(ws + WS_R1)}; \
                pg8::gemm_phase<EpiProj, pg8::SchedPlain, false, true>(F.lds + RING_OFF, g, S, E); \
                SEAM(PH_MIX_IN); } \
            if (IN(PH_MIX_A)) for (int rep_ = 0; rep_ < NREP(PH_MIX_A); ++rep_) { phase_dilated_attn(F, (const unsigned char*)(ws + WS_R1), (unsigned char*)(ws + WS_R1 + 448 * MiB), (unsigned char*)(ws + WS_R1 + 512 * MiB), (unsigned char*)(ws + WS_R2), (float*)(ws + WS_AUX)); SEAM(PH_MIX_A); } \
            if (IN(PH_MIX_B)) for (int rep_ = 0; rep_ < NREP(PH_MIX_B); ++rep_) { phase_dilated_combine(F, (const unsigned char*)(ws + WS_R1 + 448 * MiB), (const unsigned char*)(ws + WS_R1 + 512 * MiB), (const unsigned char*)(ws + WS_R2), (const float*)(ws + WS_AUX), (unsigned char*)(ws + WS_R2 + 64 * MiB)); SEAM(PH_MIX_B); } \
            if (IN(PH_MIX_OUT)) for (int rep_ = 0; rep_ < NREP(PH_MIX_OUT); ++rep_) { \
                pg8::Gemm g{(const bf16_t*)(ws + WS_R2 + 64 * MiB), (const bf16_t*)(wb + W_MIXOUT), D / 2, D / 2, D / 2}; pg8::SchedPlain S; S.init(T, D, F.G, (int)blockIdx.x, D / 2, D / 2, 0); \
                EpiBf16 E{nullptr, D, nullptr, (unsigned char*)(ws + WS_R1)}; \
                pg8::gemm_phase<EpiBf16, pg8::SchedPlain, false, true>(F.lds + RING_OFF, g, S, E); \
                SEAM(PH_MIX_OUT); } \
        } \
        if (MIXL(3) && l == 3) { \
            if (IN(PH_MIX_A)) for (int rep_ = 0; rep_ < NREP(PH_MIX_A); ++rep_) { phase_pool_diff(F, xb_in, (bf16_t*)(ws + WS_R2)); SEAM(PH_MIX_A); } \
            if (IN(PH_MIX_OUT)) for (int rep_ = 0; rep_ < NREP(PH_MIX_OUT); ++rep_) { \
                pg8::Gemm g{(const bf16_t*)(ws + WS_R2), (const bf16_t*)(wb + W_MIXOUT), D, 256, 256}; pg8::SchedPlain S; S.init(T, D, F.G, (int)blockIdx.x, D, 256, 256); \
                EpiBf16 E{nullptr, D, ain(F, IN_POOLS), (unsigned char*)(ws + WS_R1)}; \
                pg8::gemm_phase<EpiBf16, pg8::SchedPlain, false, false>(F.lds + RING_OFF, g, S, E); \
                SEAM(PH_MIX_OUT); } \
        }

#ifndef PROBE_K
#define NREP(k) 1
#else
#define NREP(k) (((PROBE_L) < 0 || (PROBE_L) == l) && (((PROBE_K) >> (k)) & 1) ? (PROBE_R) : 1)
#endif
#ifndef PROBE_DUP
#define PROBE_DUP 0
#endif
#define DUPN(k) (((PROBE_DUP) >> (k)) & 1 ? 2 : 1)
#ifndef PROBE_SKIP_EPI
#define PROBE_SKIP_EPI 0
#endif
#ifndef PH_ONLY
#define PH_ONLY -1
#endif
constexpr int PH_PER_LAYER = 16, NPHASES = DEPTH * PH_PER_LAYER;
enum { PH_CONV = 0, PH_MIX_IN = 1, PH_MIX_A = 2, PH_MIX_B = 3, PH_MIX_C = 4, PH_MIX_D = 5, PH_MIX_OUT = 6, PH_LN1 = 7, PH_ROUTER = 8, PH_ROUTE1 = 9, PH_ROUTE2 = 10,
       PH_GATEUP = 11, PH_DOWN = 12, PH_LN2 = 13, PH_PW = 14, PH_PLE = 15 };

#define wb (ws + WS_W)
__device__ __forceinline__ void launder_ptr(GAS unsigned char*& p) { asm volatile("" : "+s"(p)); }
__global__ void __launch_bounds__(NTHREADS, 2) fwd_kernel(Args args) {
    extern __shared__ __attribute__((aligned(16))) unsigned char lds[];
    Frame F;
    F.lds = (LAS unsigned char*)lds;
    F.tid = threadIdx.x; F.lane = F.tid & 63; F.wave = __builtin_amdgcn_readfirstlane(F.tid >> 6);
    F.G = gridDim.x; { const int bx = blockIdx.x; F.vcu = (F.G % 8 == 0) ? (bx % 8) * (F.G / 8) + bx / 8 : bx; }
    F.ws = (GAS unsigned char*)args.ws; F.ctl = (unsigned*)(args.ws + WS_CTL); F.out = (GAS float*)args.out;
    volatile LAS unsigned* MISC = (volatile LAS unsigned*)(F.lds + MISC_OFF);
    for (int u = F.tid; u < (LDS_BYTES - MISC_OFF) / 4; u += NTHREADS) ((LAS unsigned*)(F.lds + MISC_OFF))[u] = 0u;
    __syncthreads();
    if (F.tid == 0) {
        LAS unsigned long long* pt = (LAS unsigned long long*)(F.lds + PTAB_OFF);
#pragma unroll
        for (int i = 0; i < N_IN; ++i) pt[i] = (unsigned long long)args.in[i];
    }
    __syncthreads();
    const int lo = args.ph_lo, hi = args.ph_hi;
    XcdBarrier bar; bar.bar = F.ctl + CW_BAR; bar.x = 0; bar.st = nullptr;
    if (hi - lo > 1) bar = xcd_barrier_post(F.ctl + CW_BAR, MISC + 8);

    for (int l = 0; l < DEPTH; ++l) {
        const int pb = l * PH_PER_LAYER;
        GAS unsigned char* ws = (GAS unsigned char*)args.ws; asm volatile("" : "+s"(ws));
#define IN(k) ((PH_ONLY < 0 || PH_ONLY == (k)) && lo <= pb + (k) && pb + (k) < hi && (F.refresh(), launder_ptr(ws), true))
#define SEAM(k) do { if (pb + (k) + 1 < hi) xcd_barrier(bar); } while (0)
        bf16_t* const xb_in = (bf16_t*)(ws + ((l & 1) ? WS_XB1 : WS_XB0));
        bf16_t* const xb_mid = (bf16_t*)(ws + ((l & 1) ? WS_XB0 : WS_XB1));
        unsigned char* const x8_in = (unsigned char*)(ws + ((l & 1) ? WS_X8B : WS_X8A));
        unsigned char* const x8_out = (unsigned char*)(ws + ((l & 1) ? WS_X8A : WS_X8B));

        if (IN(PH_CONV)) for (int rep_ = 0; rep_ < NREP(PH_CONV); ++rep_) {
            if (l == 0) { phase_convert(F, args, l, CONV_MASK_ALL, F.vcu, F.G, true); SEAM(PH_CONV); }
            else { phase_convert(F, args, l, CONV_MASK_LATE, F.vcu, F.G, false); __syncthreads(); }
        }

        MIXER_PHASES

        if (IN(PH_LN1)) {
            if (HAVE_MIXER(l)) phase_ln<1>(F, xb_in, (const bf16_t*)(ws + WS_R1), ain(F, IN_LNG) + (size_t)l * 2 * D, ain(F, IN_LNB) + (size_t)l * 2 * D, xb_mid, nullptr, nullptr, 0, x8_out);
            else phase_ln<0>(F, xb_in, nullptr, ain(F, IN_LNG) + (size_t)l * 2 * D, ain(F, IN_LNB) + (size_t)l * 2 * D, xb_mid, nullptr, nullptr, 0);
            SEAM(PH_LN1);
        }
        if (IN(PH_ROUTER)) for (int rep_ = 0; rep_ < NREP(PH_ROUTER); ++rep_) {
            pg8::Gemm g{xb_mid, (const bf16_t*)(wb + W_ROUTER), D, D, D}; pg8::SchedPlain S; S.init(T, 256, F.G, (int)blockIdx.x, D, D, 0);
            EpiRouter E{(float*)(ws + WS_LOGITS)};
            pg8::gemm_phase<EpiRouter, pg8::SchedPlain, false>(F.lds + RING_OFF, g, S, E);
            if (F.G == 256) {
                F.refresh();
                pg8::Gemm g2{(const bf16_t*)(ws + WS_PBF), (const bf16_t*)(wb + W_PLEW), 256, 256, 256}; pg8::SchedPw S2; S2.c = (int)blockIdx.x; S2.lda = 256; S2.ldb = 256;
                EpiProj E2{nullptr, D, 0, nullptr, 0, -1, nullptr, nullptr, (unsigned char*)(ws + WS_R1 + 320 * MiB)};
                pg8::gemm_phase<EpiProj, pg8::SchedPw, false>(F.lds + RING_OFF, g2, S2, E2);
            } else {
                F.refresh();
                pg8::Gemm g2{(const bf16_t*)(ws + WS_PBF), (const bf16_t*)(wb + W_PLEW), 256, 256, 256}; pg8::SchedPlain S2; S2.init(T, D, F.G, (int)blockIdx.x, 256, 256, 0);
                EpiProj E2{nullptr, D, 0, nullptr, 0, -1, nullptr, nullptr, (unsigned char*)(ws + WS_R1 + 320 * MiB)};
                pg8::gemm_phase<EpiProj, pg8::SchedPlain, false>(F.lds + RING_OFF, g2, S2, E2);
            }
            SEAM(PH_ROUTER);
        }
        if (IN(PH_ROUTE1)) for (int rep_ = 0; rep_ < NREP(PH_ROUTE1); ++rep_) {
            phase_route1(F, (const float*)(ws + WS_LOGITS), ain(F, IN_RBIAS) + l * NEXP, (int*)(ws + WS_EIDX), (float*)(ws + WS_GW), (int*)(ws + WS_LRANK), (int*)(ws + WS_BLKHIST));
            SEAM(PH_ROUTE1);
        }
        if (IN(PH_ROUTE2)) for (int rep_ = 0; rep_ < NREP(PH_ROUTE2); ++rep_) {
            phase_route2(F, (const int*)(ws + WS_EIDX), (const int*)(ws + WS_LRANK), (const int*)(ws + WS_BLKHIST), (int*)(ws + WS_POSK), (int*)(ws + WS_ROWTOK), (int*)(ws + WS_TILEE), (int*)(ws + WS_MOEMETA));
            SEAM(PH_ROUTE2);
        }
        if (IN(PH_GATEUP) || IN(PH_DOWN)) {
            const int* meta = (const int*)(ws + WS_MOEMETA);
            const int ntiles = __builtin_amdgcn_readfirstlane(meta[1]);
            LAS int* tab = (LAS int*)(F.lds + TAB_OFF);
            for (int i = F.tid; i < ntiles && i < 2048; i += NTHREADS) tab[i] = ((const int*)(ws + WS_TILEE))[i];
            __syncthreads();
            if (IN(PH_GATEUP)) for (int rep_ = 0; rep_ < NREP(PH_GATEUP); ++rep_) {
                pg8::Gemm g{(const bf16_t*)x8_out, (const bf16_t*)(wb + W_EGU), D / 2, D / 2, D / 2};
                pg8::SchedMoe S; S.tile_e = tab; S.row_token = (const int*)(ws + WS_ROWTOK); S.n_units = ntiles * 2; S.npn = 2; S.G = F.G; S.c = F.vcu; S.lda = D / 2; S.ldb = D / 2;
#ifdef PROBE_HOTAB
                S.hot = 0;
#endif
                EpiSwiGLU E{(unsigned char*)(ws + WS_R2)};
                pg8::gemm_phase<EpiSwiGLU, pg8::SchedMoe, true, true>(F.lds + RING_OFF, g, S, E, F.lds + VAN_OFF);
                if (l + 1 < DEPTH) {
                    int r_ = (ntiles * 2) % F.G, ni_ = r_ ? F.G - r_ : F.G; if (ni_ < 64) { r_ = 0; ni_ = F.G; }
                    const int wi_ = F.vcu - r_;
                    if (wi_ >= 0) { F.refresh(); phase_convert(F, args, l + 1, CONV_MASK_EARLY, wi_, ni_, true); }
                }
                SEAM(PH_GATEUP);
            }
            if (IN(PH_DOWN)) for (int rep_ = 0; rep_ < NREP(PH_DOWN); ++rep_) {
                pg8::Gemm g{(const bf16_t*)(ws + WS_R2), (const bf16_t*)(wb + W_EDN), EFF / 2, EFF / 2, EFF / 2};
                pg8::SchedMoe S; S.tile_e = tab; S.row_token = nullptr; S.n_units = ntiles * 4; S.npn = 4; S.G = F.G; S.c = F.vcu; S.lda = EFF / 2; S.ldb = EFF / 2;
#ifdef PROBE_HOTAB
                S.hot = rep_ > 0 ? PROBE_HOTAB : 0;
#endif
#ifdef PROBE_Y8
                EpiY8 E{(unsigned char*)(ws + WS_R1 + (rep_ > 0 ? 384 * MiB : 0)), D, rep_ > 0 ? PROBE_Y8 : 0};
#else
                EpiY8 E{(unsigned char*)(ws + WS_R1), D};
#endif
#ifdef STAGGER_DOWN
                { const int stg_ = (F.vcu >> 3) & 3; for (int i_ = 0; i_ < stg_; ++i_) __builtin_amdgcn_s_sleep(STAGGER_DOWN); }
#endif
                pg8::gemm_phase<EpiY8, pg8::SchedMoe, false, true>(F.lds + RING_OFF, g, S, E);
                SEAM(PH_DOWN);
            }
        }
        if (IN(PH_LN2)) {
            const int shbase = __builtin_amdgcn_readfirstlane(((const int*)(ws + WS_MOEMETA))[0]);
            phase_ln<2>(F, xb_mid, (const void*)(ws + WS_R1), ain(F, IN_LNG) + (size_t)l * 2 * D + D, ain(F, IN_LNB) + (size_t)l * 2 * D + D, xb_in, (const int*)(ws + WS_POSK), (const float*)(ws + WS_GW), shbase, x8_in);
            SEAM(PH_LN2);
        }
        if (IN(PH_PLE)) {
            pg8::Gemm g{(const bf16_t*)x8_in, (const bf16_t*)(wb + W_PLEG), D / 2, D / 2, D / 2}; pg8::SchedPlain S; S.init(T, D, F.G, (int)blockIdx.x, D / 2, D / 2, 0);
            EpiPLE E{xb_in, (const unsigned char*)(ws + WS_R1 + 320 * MiB), xb_mid, (l == DEPTH - 1) ? (float*)F.out : (float*)nullptr, x8_out};
            pg8::gemm_phase<EpiPLE, pg8::SchedPlain, false, true>(F.lds + RING_OFF, g, S, E);
            SEAM(PH_PLE);
        }
#undef IN
#undef SEAM
    }
}

extern "C" void kernel_launch(void* const* d_in, const int* in_sizes, int n_in, void* d_out, int out_size, void* d_ws, size_t ws_size, hipStream_t stream) {
    static int grid = 0;
    if (grid == 0) {
        if (n_in != N_IN || out_size != T * D || ws_size < WS_END) { fprintf(stderr, "kernel_launch: bad shapes: n_in %d out %d ws %zu (need %zu)\n", n_in, out_size, ws_size, (size_t)WS_END); grid = -1; return; }
        int dev = 0, cus = 0, per_cu = 0;
        if (hipGetDevice(&dev) != hipSuccess || hipDeviceGetAttribute(&cus, hipDeviceAttributeMultiprocessorCount, dev) != hipSuccess) { grid = -1; return; }
        if (hipFuncSetAttribute((const void*)fwd_kernel, hipFuncAttributeMaxDynamicSharedMemorySize, LDS_BYTES) != hipSuccess) { fprintf(stderr, "kernel_launch: hipFuncSetAttribute failed\n"); grid = -1; return; }
        if (hipOccupancyMaxActiveBlocksPerMultiprocessor(&per_cu, (const void*)fwd_kernel, NTHREADS, LDS_BYTES) != hipSuccess || per_cu < 1) fprintf(stderr, "kernel_launch: occupancy query says %d\n", per_cu);
        (void)hipGetLastError();
        grid = cus;
    }
    if (grid < 0) return;
    (void)hipMemsetAsync((char*)d_ws + WS_CTL, 0, CTL_ZERO_BYTES, stream);
    Args a{};
    for (int i = 0; i < N_IN; ++i) a.in[i] = (const float*)d_in[i];
    a.out = (float*)d_out; a.ws = (unsigned char*)d_ws;
#if ONE_LAUNCH
    a.ph_lo = 0; a.ph_hi = NPHASES;
    hipLaunchKernelGGL(fwd_kernel, dim3(grid), dim3(NTHREADS), LDS_BYTES, stream, a);
#else
    for (int ph = 0; ph < NPHASES; ++ph) {
        if (!phase_used(ph)) continue;
        a.ph_lo = ph; a.ph_hi = ph + 1;
        hipLaunchKernelGGL(fwd_kernel, dim3(grid), dim3(NTHREADS), LDS_BYTES, stream, a);
    }
#endif
}
```

```cpp
#include <hip/hip_runtime.h>
#include <cstdio>
#include <cstdint>

#define LAS __attribute__((address_space(3)))
#define GAS __attribute__((address_space(1)))
typedef unsigned short bf16_t;
typedef short bf16x8 __attribute__((ext_vector_type(8)));
typedef short bf16x4 __attribute__((ext_vector_type(4)));
typedef float f32x4 __attribute__((ext_vector_type(4)));
typedef float f32x2 __attribute__((ext_vector_type(2)));
typedef unsigned u32x4 __attribute__((ext_vector_type(4)));
typedef unsigned u32x2 __attribute__((ext_vector_type(2)));

typedef __bf16 bf16v2_t __attribute__((ext_vector_type(2)));
__device__ __forceinline__ unsigned cvt_pk_bf16(float lo, float hi) { const f32x2 v = {lo, hi}; return __builtin_bit_cast(unsigned, __builtin_convertvector(v, bf16v2_t)); }
__device__ __forceinline__ unsigned pk4_fp8(float a, float b, float c, float d) {
    a = __builtin_fminf(__builtin_fmaxf(a, -448.f), 448.f); b = __builtin_fminf(__builtin_fmaxf(b, -448.f), 448.f);
    c = __builtin_fminf(__builtin_fmaxf(c, -448.f), 448.f); d = __builtin_fminf(__builtin_fmaxf(d, -448.f), 448.f);
    int w = 0; w = __builtin_amdgcn_cvt_pk_fp8_f32(a, b, w, false); w = __builtin_amdgcn_cvt_pk_fp8_f32(c, d, w, true); return (unsigned)w; }
__device__ __forceinline__ float bf2f(unsigned short b) { return __uint_as_float(((unsigned)b) << 16); }
__device__ __forceinline__ float bflo(unsigned w) { return __uint_as_float(w << 16); }
__device__ __forceinline__ float bfhi(unsigned w) { return __uint_as_float(w & 0xffff0000u); }
__device__ __forceinline__ float fast_exp2(float x) { return __builtin_amdgcn_exp2f(x); }
__device__ __forceinline__ float fast_rcp(float x) { return __builtin_amdgcn_rcpf(x); }
__device__ __forceinline__ float fexp(float x) { return fast_exp2(1.44269504f * x); }
__device__ __forceinline__ float flog(float x) { return __builtin_amdgcn_logf(x) * 0.69314718f; }
__device__ __forceinline__ float frsq(float x) { return __builtin_amdgcn_rsqf(x); }
__device__ __forceinline__ float sigmoidf_(float x) { return fast_rcp(1.0f + fast_exp2(-1.44269504f * x)); }

namespace pg8 {
constexpr int BM = 256, BK = 64, HALF = 128, HTB = HALF * BK * 2  , STAGE_BYTES = 8 * HTB, NXCD = 8, WGM = 8;
__host__ __device__ __forceinline__ int lds_byte(int r, int c) { const int st = (r >> 4) * 2 + (c >> 5), rr = r & 15, cc = c & 31, ob = rr * 64 + cc * 2; return st * 1024 + (ob ^ (((ob >> 9) & 1) << 5)); }
__host__ __device__ __forceinline__ void stage_rc(int b, int& R, int& C) { const int st = b / 1024, sb = b % 1024, swz = sb ^ (((sb >> 9) & 1) << 5); R = (st >> 1) * 16 + swz / 64; C = (st & 1) * 32 + (swz % 64) / 2; }
__host__ __device__ __forceinline__ int perm32(int rho) { const int n = rho >> 4, i = rho & 15; return 8 * (i >> 2) + 4 * n + (i & 3); }

struct Unit { int pm, pn, e; };
struct Gemm { const bf16_t* A; const bf16_t* Bt; int lda, ldb, K; };

struct SchedPlain {
    int nM, nN, nwg, G, c, lda, ldb, acs;
    __device__ void init(int M, int N, int G_, int c_, int lda_, int ldb_, int acs_) { nM = M / BM; nN = N / BM; nwg = nM * nN; G = G_; c = c_; lda = lda_; ldb = ldb_; acs = acs_; }
    __device__ __forceinline__ bool next(int i, Unit& u) const {
        const long L = (long)i * G + c; if (L >= nwg) return false;
        int wgid = (int)L; { const int q = nwg / NXCD, r = nwg % NXCD, xcd = wgid % NXCD, off = wgid / NXCD; wgid = (xcd < r ? xcd * (q + 1) : r * (q + 1) + (xcd - r) * q) + off; }
        const int nig = WGM * nN, gid = wgid / nig, fm = gid * WGM, gsz = (nM - fm) < WGM ? (nM - fm) : WGM;
        u.pm = fm + ((wgid % nig) % gsz); u.pn = (wgid % nig) / gsz; u.e = 0; return true;
    }
    __device__ __forceinline__ size_t aoff(const Unit& u) const { return ((size_t)u.pm * BM * lda + (size_t)u.pn * acs) * 2; }
    __device__ __forceinline__ size_t boff(const Unit& u) const { return (size_t)u.pn * BM * ldb * 2; }
    __device__ __forceinline__ const int* rows(const Unit&) const { return nullptr; }
};
struct SchedSimple {
    int nN, nwg, G, c, lda, ldb, acs;
    __device__ void init(int M, int N, int G_, int c_, int lda_, int ldb_, int acs_) { nN = N / BM; nwg = (M / BM) * nN; G = G_; c = c_; lda = lda_; ldb = ldb_; acs = acs_; }
    __device__ __forceinline__ bool next(int i, Unit& u) const { const int L = i * G + c; if (L >= nwg) return false; u.pm = L / nN; u.pn = L - u.pm * nN; u.e = 0; return true; }
    __device__ __forceinline__ size_t aoff(const Unit& u) const { return ((size_t)u.pm * BM * lda + (size_t)u.pn * acs) * 2; }
    __device__ __forceinline__ size_t boff(const Unit& u) const { return (size_t)u.pn * BM * ldb * 2; }
    __device__ __forceinline__ const int* rows(const Unit&) const { return nullptr; }
};
struct SchedPw {
    int c, lda, ldb;
    __device__ __forceinline__ bool next(int i, Unit& u) const {
        int L; if (c >= 128) { if (i >= 3) return false; L = 3 * (c - 128) + i; } else { if (i >= 1) return false; L = 384 + c; }
        u.pm = L >> 2; u.pn = L & 3; u.e = 0; return true;
    }
    __device__ __forceinline__ size_t aoff(const Unit& u) const { return (size_t)u.pm * BM * lda * 2; }
    __device__ __forceinline__ size_t boff(const Unit& u) const { return (size_t)u.pn * BM * ldb * 2; }
    __device__ __forceinline__ const int* rows(const Unit&) const { return nullptr; }
};
struct SchedMoe {
    const LAS int* tile_e; const int* row_token; int n_units, npn, G, c, lda, ldb, rev;
    __device__ __forceinline__ bool next(int i, Unit& u) const {
        long L = (long)i * G + c; if (L >= n_units) return false;
        if (rev) { const int pmr = (n_units / npn) - 1 - (int)(L / npn); u.pm = pmr; u.pn = (int)L % npn; u.e = tile_e[u.pm]; return true; }
        u.pm = (int)L / npn; u.pn = (int)L % npn; u.e = tile_e[u.pm]; return true;
    }
#ifdef PROBE_HOTAB
    int hot;
    __device__ __forceinline__ size_t aoff(const Unit& u) const { return (hot & 1) ? (size_t)0 : (size_t)u.pm * BM * lda * 2; }
    __device__ __forceinline__ size_t boff(const Unit& u) const { return (hot & 2) ? (size_t)0 : ((size_t)u.e * npn + u.pn) * BM * ldb * 2; }
#else
    __device__ __forceinline__ size_t aoff(const Unit& u) const { return (size_t)u.pm * BM * lda * 2; }
    __device__ __forceinline__ size_t boff(const Unit& u) const { return ((size_t)u.e * npn + u.pn) * BM * ldb * 2; }
#endif
    __device__ __forceinline__ const int* rows(const Unit& u) const { return row_token + (size_t)u.pm * BM; }
};


typedef int v8i_t __attribute__((ext_vector_type(8)));
typedef int v4i_t __attribute__((ext_vector_type(4)));
constexpr int W8_EXP = 121;
template <class Epi, class Sched, bool GATHER, bool FP8 = false>
__device__ __forceinline__ void gemm_phase(LAS unsigned char* lds, const Gemm g, const Sched& S, const Epi& E, LAS unsigned char* van = nullptr) {
    int tid_ = threadIdx.x; asm volatile("" : "+v"(tid_));
    const int tid = tid_, wid = __builtin_amdgcn_readfirstlane(tid >> 6), lane = tid & 63, wr = wid >> 2, wc = wid & 3, fr = lane & 15, fq = lane >> 4;
    const int K = g.K, nt = K / BK;
    unsigned voffA[2], voffB[2];
#pragma unroll
    for (int i = 0; i < 2; ++i) { int R, C; stage_rc(tid * 16 + i * 8192, R, C);
        voffA[i] = (unsigned)(R * g.lda + C) * 2u;
        { const int sg = 64 * (R >> 5) + 16 * ((R >> 2) & 3) + 4 * ((R >> 4) & 1) + (R & 3); voffB[i] = (unsigned)(sg * g.ldb + C) * 2u; } }
    const size_t hstepB = (size_t)8 * g.ldb * 2;
    unsigned vAc[2][2];
    const size_t kstep = (size_t)(BK * 2);
    const size_t hstepA = GATHER ? (size_t)0 : (size_t)HALF * g.lda * 2;
    const unsigned ldsw = (unsigned)wid * 1024u;
    const int aoff = lds_byte(wr * 64 + fr, fq * 8), boff = lds_byte(wc * 32 + fr, fq * 8);
    const int a8o0 = lds_byte(wr * 64 + fr, 16 * (fq & 1)) + (fq >> 1) * 1024;
    const int b8o0 = lds_byte(wc * 32 + fr, 16 * (fq & 1)) + (fq >> 1) * 1024;
    unsigned la8_ = (unsigned)(size_t)lds + (unsigned)a8o0, lb8_ = (unsigned)(size_t)lds + 65536u + (unsigned)b8o0;
    if constexpr (FP8) { asm volatile("" : "+v"(la8_), "+v"(lb8_)); }
    const LAS unsigned char* const la8 = (const LAS unsigned char*)(size_t)la8_; const LAS unsigned char* const lb8 = (const LAS unsigned char*)(size_t)lb8_;
#define PG8_SA(b, h) (((b) * 2 + (h)) * HTB)
#define PG8_SB(b, h) ((4 + (b) * 2 + (h)) * HTB)
#define PG8_STAGE(bufoff, gbase, voff) do { _Pragma("unroll") for (int _i = 0; _i < 2; ++_i) \
        __builtin_amdgcn_global_load_lds((const unsigned*)((const char*)(gbase) + (voff)[_i]), (LAS unsigned*)(lds + (bufoff) + ldsw + _i * 8192), 16, 0, 0); } while (0)
#define PG8_STAGEA(bufoff, gbase, h) do { if constexpr (GATHER) { PG8_STAGE(bufoff, gbase, vAc[h]); } else { PG8_STAGE(bufoff, (gbase) + (h) * hstepA, voffA); } } while (0)

#define PG8_LD32(p) __builtin_shufflevector(*(const LAS v4i_t*)(p), *(const LAS v4i_t*)((p) + 16), 0, 1, 2, 3, 4, 5, 6, 7)
#define PG8_LD8(dst, off0, off1) do { dst = *(const LAS v8i_t*)(lds + (off0)); } while (0)
#define PG8_LDA(dst, b, h) do { if constexpr (FP8) { _Pragma("unroll") for (int m = 0; m < 4; ++m) dst##8[m] = PG8_LD32(la8 + PG8_SA(b, h) + m * 2048); } else { \
        _Pragma("unroll") for (int m = 0; m < 4; ++m) _Pragma("unroll") for (int k = 0; k < 2; ++k) dst[m][k] = *(const LAS bf16x8*)(lds + PG8_SA(b, h) + aoff + m * 2048 + k * 1024); } } while (0)
#define PG8_LDB(dst, b, h) do { if constexpr (FP8) { _Pragma("unroll") for (int n = 0; n < 2; ++n) dst##8[n] = PG8_LD32(lb8 + (PG8_SB(b, h) - 65536) + n * 2048); } else { \
        _Pragma("unroll") for (int n = 0; n < 2; ++n) _Pragma("unroll") for (int k = 0; k < 2; ++k) dst[n][k] = *(const LAS bf16x8*)(lds + PG8_SB(b, h) + boff + n * 2048 + k * 1024); } } while (0)
#define PG8_MMA(ai, bj, At, Bt) do { __builtin_amdgcn_s_setprio(1); if constexpr (FP8) { _Pragma("unroll") for (int m = 0; m < 4; ++m) _Pragma("unroll") for (int n = 0; n < 2; ++n) \
        asm volatile("v_mfma_scale_f32_16x16x128_f8f6f4 %0, %1, %2, %0, %3, %4 op_sel_hi:[0,0,0]" : "+v"(acc[ai][bj][m][n]) : "v"(Bt##8[n]), "v"(At##8[m]), "v"(sclw), "v"(scla)); } else { \
        _Pragma("unroll") for (int m = 0; m < 4; ++m) _Pragma("unroll") for (int n = 0; n < 2; ++n) _Pragma("unroll") for (int k = 0; k < 2; ++k) \
        acc[ai][bj][m][n] = __builtin_amdgcn_mfma_f32_16x16x32_bf16(Bt[n][k], At[m][k], acc[ai][bj][m][n], 0, 0, 0); } __builtin_amdgcn_s_setprio(0); } while (0)
#define PG8_MFMA_DRAIN() do { if constexpr (FP8) asm volatile("s_nop 15\n\ts_nop 7" ::: "memory"); } while (0)
#define PG8_WAIT_V(n) asm volatile("s_waitcnt vmcnt(" #n ")" ::: "memory")
#define PG8_WAIT_L(n) asm volatile("s_waitcnt lgkmcnt(" #n ")" ::: "memory")
#define PG8_BAR __builtin_amdgcn_s_barrier()
#define PG8_SCHED __builtin_amdgcn_sched_barrier(0)
#define PG8_LOADROWS(dst, u) do { const int* _rw = S.rows(u); _Pragma("unroll") for (int _i = 0; _i < 2; ++_i) { int _R, _C; stage_rc(tid * 16 + _i * 8192, _R, _C);   \
        _Pragma("unroll") for (int _h = 0; _h < 2; ++_h) dst[_h][_i] = (unsigned)(_rw[_h * HALF + _R] * g.lda + _C) * 2u; } } while (0)
    Unit cur, nxt; int ui = 0;
    if (!S.next(0, cur)) return;
    f32x4 acc[2][2][4][2];
#pragma unroll
    for (int a = 0; a < 2; ++a)
#pragma unroll
        for (int b = 0; b < 2; ++b)
#pragma unroll
            for (int m = 0; m < 4; ++m)
#pragma unroll
                for (int n = 0; n < 2; ++n) acc[a][b][m][n] = (f32x4){0.f, 0.f, 0.f, 0.f};
    bf16x8 At[4][2], B0[2][2], B1[2][2];
    v8i_t At8[4], B08[2], B18[2];
    int sclw = W8_EXP * 0x01010101, scla = 127 * 0x01010101;
    if constexpr (FP8) { asm volatile("" : "+v"(sclw), "+v"(scla)); }
    const char* cA = (const char*)g.A + (GATHER ? (size_t)0 : S.aoff(cur)); const char* cB = (const char*)g.Bt + S.boff(cur);
    if constexpr (GATHER) { Unit u1; if (wid == 0 && S.next(1, u1))
            __builtin_amdgcn_global_load_lds((const unsigned*)(S.rows(u1) + lane * 4), (LAS unsigned*)(lds + 149504 + 1024), 16, 0, 0);
        PG8_LOADROWS(vAc, cur); }
    PG8_STAGE(PG8_SB(0, 0), cB, voffB); PG8_STAGE(PG8_SB(0, 1), cB + hstepB, voffB); PG8_STAGEA(PG8_SA(0, 0), cA, 0); PG8_STAGEA(PG8_SA(0, 1), cA, 1);
    if (wr == 1) PG8_BAR;
    PG8_WAIT_V(2); PG8_BAR;
    PG8_STAGE(PG8_SB(1, 0), cB + kstep, voffB); PG8_STAGEA(PG8_SA(1, 0), cA + kstep, 0); PG8_STAGE(PG8_SB(1, 1), cB + hstepB + kstep, voffB);
    PG8_WAIT_V(6); PG8_BAR;
    for (;;) {
        const bool has_next = S.next(ui + 1, nxt);
        const char* nA = (has_next && !GATHER) ? (const char*)g.A + S.aoff(nxt) : cA; const char* nB = has_next ? (const char*)g.Bt + S.boff(nxt) : cB;
        if constexpr (GATHER) { Unit u2; if (wid == 0 && S.next(ui + 2, u2))
            __builtin_amdgcn_global_load_lds((const unsigned*)(S.rows(u2) + lane * 4), (LAS unsigned*)(lds + 149504 + (ui & 1) * 1024), 16, 0, 0); }
#pragma clang loop unroll(disable)
        for (int t = 0; t < nt; t += 2) {
            const bool last = (t == nt - 2);
            const char* a1 = cA + (size_t)(t + 1) * kstep;
            const char* a2 = last ? nA : cA + (size_t)(t + 2) * kstep; const char* b2 = last ? nB : cB + (size_t)(t + 2) * kstep;
            const char* a3 = a2 + kstep; const char* b3 = b2 + kstep;
            PG8_LDB(B0, 0, 0); PG8_LDB(B1, 0, 1); PG8_SCHED; PG8_LDA(At, 0, 0); PG8_STAGEA(PG8_SA(1, 1), a1, 1);
            if constexpr (GATHER) { if (last && has_next) { const LAS int* rt_ = (const LAS int*)(lds + 149504 + ((ui + 1) & 1) * 1024);
#pragma unroll
                for (int i_ = 0; i_ < 2; ++i_) { int R_, C_; stage_rc(tid * 16 + i_ * 8192, R_, C_);
#pragma unroll
                    for (int h_ = 0; h_ < 2; ++h_) vAc[h_][i_] = (unsigned)(rt_[h_ * HALF + R_] * g.lda + C_) * 2u; } } }
            PG8_WAIT_V(8); PG8_WAIT_L(0); PG8_BAR; PG8_MMA(0, 0, At, B0); PG8_MMA(0, 1, At, B1); PG8_BAR; PG8_SCHED;
            PG8_LDA(At, 0, 1); PG8_STAGE(PG8_SB(0, 0), b2, voffB); PG8_STAGE(PG8_SB(0, 1), b2 + hstepB, voffB); PG8_STAGEA(PG8_SA(0, 0), a2, 0);
            PG8_WAIT_V(8); PG8_WAIT_L(0); PG8_BAR; PG8_MMA(1, 0, At, B0); PG8_MMA(1, 1, At, B1); PG8_BAR; PG8_SCHED;
            PG8_LDB(B0, 1, 0); PG8_LDB(B1, 1, 1); PG8_SCHED; PG8_LDA(At, 1, 0); PG8_STAGEA(PG8_SA(0, 1), a2, 1);
            PG8_WAIT_V(8); PG8_WAIT_L(0); PG8_BAR; PG8_MMA(0, 0, At, B0); PG8_MMA(0, 1, At, B1); PG8_BAR; PG8_SCHED;
            PG8_LDA(At, 1, 1); PG8_STAGE(PG8_SB(1, 0), b3, voffB); PG8_STAGE(PG8_SB(1, 1), b3 + hstepB, voffB); PG8_STAGEA(PG8_SA(1, 0), a3, 0);
            PG8_WAIT_V(8); PG8_WAIT_L(0); PG8_BAR; PG8_MMA(1, 0, At, B0); PG8_MMA(1, 1, At, B1); PG8_BAR; PG8_SCHED;
        }
        if (wr == 0) PG8_BAR;
        PG8_MFMA_DRAIN();
        E(acc, cur, wr, wc, fr, fq);
        if (!has_next) break;
#pragma unroll
        for (int a = 0; a < 2; ++a)
#pragma unroll
            for (int b = 0; b < 2; ++b)
#pragma unroll
                for (int m = 0; m < 4; ++m)
#pragma unroll
                    for (int n = 0; n < 2; ++n) acc[a][b][m][n] = (f32x4){0.f, 0.f, 0.f, 0.f};
        cur = nxt; cA = nA; cB = nB; ++ui;
        if (wr == 1) PG8_BAR;
    }
    PG8_WAIT_V(0);
    PG8_BAR;
#undef PG8_SA
#undef PG8_SB
#undef PG8_STAGE
#undef PG8_STAGEA
#undef PG8_LDA
#undef PG8_LD8
#undef PG8_LD32
#undef PG8_LDB
#undef PG8_MMA
#undef PG8_MFMA_DRAIN
#undef PG8_WAIT_V
#undef PG8_WAIT_L
#undef PG8_BAR
#undef PG8_SCHED
#undef PG8_LOADROWS
}
}

constexpr int NB = 8, SEQ = 4096, D = 1024, T = NB * SEQ, DEPTH = 4;
constexpr float ALPHA = 1.6817928305074292f;
constexpr float LN_EPS = 1e-5f;
constexpr float NEG_BIG = -1e30f;
constexpr int NEXP = 64, TOPK = 8, EFF = 256;
constexpr int NWAVES = 8, NTHREADS = 512;

constexpr size_t MiB = 1u << 20;
constexpr size_t WS_CTL = 0, CTL_ZERO_BYTES = 1 * MiB;
constexpr size_t WS_ROPE = 1 * MiB;
constexpr size_t WS_LOGITS = 2 * MiB;
constexpr size_t WS_EIDX = 10 * MiB;
constexpr size_t WS_GW = 11 * MiB;
constexpr size_t WS_LRANK = 12 * MiB;
constexpr size_t WS_POSK = 13 * MiB;
constexpr size_t WS_ROWTOK = 14 * MiB;
constexpr size_t WS_BLKHIST = 15 * MiB + 512 * 1024;
constexpr size_t WS_TILEE = 15 * MiB + 640 * 1024;
constexpr size_t WS_MOEMETA = 15 * MiB + 704 * 1024;
constexpr size_t WS_AUX = 16 * MiB;
constexpr size_t WS_MSC = 22 * MiB;
constexpr size_t WS_PBF = 26 * MiB;
constexpr size_t WS_W = 49 * MiB;
constexpr size_t WS_XB0 = 169 * MiB, WS_XB1 = 233 * MiB;
constexpr size_t WS_R1 = 297 * MiB;
constexpr size_t WS_R2 = 905 * MiB;
constexpr size_t WS_X8A = 1057 * MiB, WS_X8B = 1089 * MiB;
constexpr size_t WS_END = 1121 * MiB;
constexpr size_t W_EGU = 0;
constexpr size_t W_EDN = 65 * MiB;
constexpr size_t W_ROUTER = 98 * MiB;
constexpr size_t W_PLEG = 99 * MiB;
constexpr size_t W_PLEW = 101 * MiB;
constexpr size_t W_MIXIN = 102 * MiB;
constexpr size_t W_MIXOUT = 116 * MiB;
constexpr size_t W_CMPK = 118 * MiB;
constexpr size_t W_CMPV = 118 * MiB + 512 * 1024;
constexpr size_t W_CMPB = 119 * MiB;

constexpr int CW_TMO = 0;
constexpr int CW_BAR = 4096;

constexpr int RING_OFF = 0, RING_BYTES = 131072;
constexpr int TAB_OFF = RING_BYTES;
constexpr int MISC_OFF = RING_BYTES + 8192;
constexpr int PTAB_OFF = MISC_OFF + 256;
constexpr int VAN_OFF = MISC_OFF + 1024;
constexpr int LDS_BYTES = 163840;

#define RLX_AGENT __ATOMIC_RELAXED, __HIP_MEMORY_SCOPE_AGENT
#define LDS_WAIT() asm volatile("s_waitcnt lgkmcnt(0)" ::: "memory")
#define VM_WAIT() asm volatile("s_waitcnt vmcnt(0)" ::: "memory")
__device__ __forceinline__ unsigned f2bf(float f) { unsigned u = __builtin_bit_cast(unsigned, f); return (u + 0x7fffu + ((u >> 16) & 1u)) >> 16; }
__device__ __forceinline__ unsigned pk2(float lo, float hi) { return f2bf(lo) | (f2bf(hi) << 16); }

#define XB_TMO      128
#define XB_XCNT(j)  (256  + 64 * (j))
#define XB_XSUB(j)  (1280 + 64 * (j))
#define XB_XGEN(j)  (2304 + 64 * (j))
#define XB_TOP      3328
#define XB_TOPGEN   3392
#define XCD_BAR_WORDS 3456
#define XB_SPIN_CAP (1u << 18)

__device__ __forceinline__ unsigned xb_ld(unsigned* p)              { return __hip_atomic_load(p, __ATOMIC_RELAXED, __HIP_MEMORY_SCOPE_AGENT); }
__device__ __forceinline__ unsigned xb_add(unsigned* p, unsigned v) { return __hip_atomic_fetch_add(p, v, __ATOMIC_RELAXED, __HIP_MEMORY_SCOPE_AGENT); }
__device__ __forceinline__ unsigned xb_xcc_id() { return (unsigned)__builtin_amdgcn_s_getreg((3 << 11) | 20) & 0xFu; }
#define XB_SPIN(cond, bar) do { unsigned _sp = 0; while (cond) { __builtin_amdgcn_s_sleep(1); \
    if ((++_sp & 255u) == 0u) { if (xb_ld(&(bar)[XB_TMO])) break; if (_sp > XB_SPIN_CAP) { atomicAdd(&(bar)[XB_TMO], 1u); break; } } } } while (0)

struct XcdBarrier { unsigned* bar; unsigned x; volatile LAS unsigned* st; };

__device__ __forceinline__ XcdBarrier xcd_barrier_post(unsigned* bar, volatile LAS unsigned* st) {
    XcdBarrier b; b.bar = bar; b.x = xb_xcc_id(); b.st = st;
    if (threadIdx.x == 0) (void)xb_add(&bar[XB_XCNT(b.x)], 1u);
    return b;
}
__device__ __forceinline__ void xcd_barrier_complete(unsigned* bar, unsigned x, unsigned& nloc, unsigned& nx) {
    const unsigned G = gridDim.x * gridDim.y * gridDim.z;
    unsigned sum, cnt, mine, sp = 0u;
    for (;;) {
        sum = 0u; cnt = 0u; mine = 0u;
#pragma unroll
        for (unsigned j = 0; j < 16; ++j) { const unsigned c = xb_ld(&bar[XB_XCNT(j)]); sum += c; cnt += (c > 0u) ? 1u : 0u; mine = (j == x) ? c : mine; }
        if (sum == G) break;
        __builtin_amdgcn_s_sleep(1);
        if ((++sp & 255u) == 0u) { if (xb_ld(&bar[XB_TMO])) break; if (sp > XB_SPIN_CAP) { atomicAdd(&bar[XB_TMO], 1u); break; } }
    }
    nloc = mine > 0u ? mine : 1u; nx = cnt > 0u ? cnt : 1u;
}
__device__ __forceinline__ void xcd_barrier(const XcdBarrier& b) {
    asm volatile("s_waitcnt vmcnt(0)" ::: "memory");
    __syncthreads();
    if (threadIdx.x == 0) {
        unsigned* bar = b.bar; asm volatile("" : "+s"(bar));
        __builtin_amdgcn_s_waitcnt(0);
        unsigned nloc = b.st[0], nx = b.st[1];
        if (nloc == 0u) { xcd_barrier_complete(bar, b.x, nloc, nx); b.st[0] = nloc; b.st[1] = nx; }
        const unsigned old = xb_add(&bar[XB_XSUB(b.x)], 1u);
        const unsigned gen = old / nloc;
        if (old + 1u == (gen + 1u) * nloc) {
            __builtin_amdgcn_fence(__ATOMIC_RELEASE, "agent");
            asm volatile("s_waitcnt vmcnt(0)" ::: "memory");
            const unsigned og = xb_add(&bar[XB_TOP], 1u);
            const unsigned tg = og / nx;
            if (og + 1u == (tg + 1u) * nx) xb_add(&bar[XB_TOPGEN], 1u);
            else XB_SPIN(xb_ld(&bar[XB_TOPGEN]) == tg, bar);
            __builtin_amdgcn_fence(__ATOMIC_ACQUIRE, "agent");
            xb_add(&bar[XB_XGEN(b.x)], 1u);
            asm volatile("s_waitcnt vmcnt(0)" ::: "memory");
        } else {
            XB_SPIN(xb_ld(&bar[XB_XGEN(b.x)]) == gen, bar);
            __builtin_amdgcn_fence(__ATOMIC_ACQUIRE, "agent");
            asm volatile("s_waitcnt vmcnt(0)" ::: "memory");
        }
    }
    __syncthreads();
}

struct Args { const float* in[30]; float* out; unsigned char* ws; int ph_lo, ph_hi; };
struct Frame {
    LAS unsigned char* lds;
    GAS unsigned char* ws;
    unsigned* ctl;
    int tid, lane, wave, ptb;
    __device__ __forceinline__ void refresh() { int t = threadIdx.x; asm volatile("" : "+v"(t)); tid = t; lane = t & 63; wave = __builtin_amdgcn_readfirstlane(t >> 6);
        int z = 0; asm volatile("" : "+v"(z)); ptb = PTAB_OFF + z; }
    int vcu, G;
    GAS float* out;
};

__device__ __forceinline__ const float* ain(const Frame& F, int i) {
    const volatile LAS unsigned* q = (const volatile LAS unsigned*)(F.lds + F.ptb + 8 * i);
    const unsigned lo = __builtin_amdgcn_readfirstlane(q[0]), hi = __builtin_amdgcn_readfirstlane(q[1]);
    return (const float*)(((unsigned long long)hi << 32) | lo);
}
__device__ __forceinline__ const float* ain_g(const Frame& F, int i) {
    const volatile LAS unsigned* q = (const volatile LAS unsigned*)(F.lds + F.ptb + 8 * i);
    const unsigned lo = __builtin_amdgcn_readfirstlane(q[0]), hi = __builtin_amdgcn_readfirstlane(q[1]);
    return (const float*)(GAS const float*)(((unsigned long long)hi << 32) | lo);
}
#define DPP_F(old, src, ctrl, rmask) __builtin_bit_cast(float, __builtin_amdgcn_update_dpp(__builtin_bit_cast(int, (float)(old)), __builtin_bit_cast(int, (float)(src)), ctrl, rmask, 0xf, false))
__device__ __forceinline__ float wave_max_dpp(float v) {
    const float ninf = -3.0e38f;
    v = fmaxf(v, DPP_F(ninf, v, 0x111, 0xf)); v = fmaxf(v, DPP_F(ninf, v, 0x112, 0xf)); v = fmaxf(v, DPP_F(ninf, v, 0x114, 0xf)); v = fmaxf(v, DPP_F(ninf, v, 0x118, 0xf));
    v = fmaxf(v, DPP_F(ninf, v, 0x142, 0xa));
    v = fmaxf(v, DPP_F(ninf, v, 0x143, 0xc));
    return __builtin_bit_cast(float, __builtin_amdgcn_readlane(__builtin_bit_cast(int, v), 63));
}
__device__ __forceinline__ float wave_sum_dpp(float v) {
    v += DPP_F(0.f, v, 0x111, 0xf); v += DPP_F(0.f, v, 0x112, 0xf); v += DPP_F(0.f, v, 0x114, 0xf); v += DPP_F(0.f, v, 0x118, 0xf);
    v += DPP_F(0.f, v, 0x142, 0xa);
    v += DPP_F(0.f, v, 0x143, 0xc);
    return __builtin_bit_cast(float, __builtin_amdgcn_readlane(__builtin_bit_cast(int, v), 63));
}
__device__ __forceinline__ float group8_max_dpp(float v, int lane) {
    v = fmaxf(v, DPP_F(v, v, 0xB1, 0xf));
    v = fmaxf(v, DPP_F(v, v, 0x4E, 0xf));
    const float up = DPP_F(v, v, 0x12C, 0xf), dn = DPP_F(v, v, 0x124, 0xf);
    return fmaxf(v, (lane & 4) ? dn : up);
}
__device__ __forceinline__ float wave_sum(float v) {
#pragma unroll
    for (int o = 1; o < 64; o <<= 1) v += __shfl_xor(v, o);
    return v;
}
__device__ __forceinline__ float wave_max(float v) {
#pragma unroll
    for (int o = 1; o < 64; o <<= 1) v = fmaxf(v, __shfl_xor(v, o));
    return v;
}

enum { IN_X = 0, IN_P, IN_LNG, IN_LNB, IN_MW_IN, IN_MCONV, IN_MIGB, IN_MFGB, IN_MNORMG, IN_MW_OUT, IN_NW_IN, IN_NPOSK, IN_NPOSV, IN_NWK, IN_NWV, IN_NW_OUT,
       IN_DW_IN, IN_DW_OUT, IN_POOLW, IN_POOLS, IN_ROUTER, IN_RBIAS, IN_EG, IN_EU, IN_ED, IN_SG, IN_SU, IN_SD, IN_PLEW, IN_PLEG, N_IN };

__device__ __forceinline__ int rope_phi(int d) { return d < 32 ? 16 * (d >> 3) + (d & 7) : 16 * ((d - 32) >> 3) + 8 + ((d - 32) & 7); }

struct ConvTask { const float* W; bf16_t* WT; long wstride; int K, N, nbatch, ldwt, kind, p0, nitems, pad; };
__device__ __forceinline__ int conv_rowmap(int kind, int p0, int N, int batch, int n) {
    if (kind == 0) return p0 + batch * N + n;
    if (kind == 2) return (batch + (p0 >> 16)) * 512 + (n >> 7) * 256 + 16 * ((n & 127) >> 3) + (n & 7) + (p0 & 0xffff);
    bool rp;
    if (kind == 3) rp = (n < 1024) || (n >= 1536 && n < 1792) || (n >= 2048 && n < 2304); else rp = (n < 6144);
    return rp ? ((n & ~63) + rope_phi(n & 63)) : n;
}
__device__ __forceinline__ void conv_load(const ConvTask& t, int item, int lane, float (&v)[32]) {
    const int nblk = (t.N + 31) / 32, kblk = t.K / 64, per = nblk * kblk;
    const int batch = item / per, r = item % per, kb = r / nblk, nb = r % nblk, k0 = 64 * kb, n0 = 32 * nb;
    const int ncol = n0 + (lane & 31); const bool nok = ncol < t.N;
    const float* W = t.W + (size_t)batch * t.wstride + (size_t)(k0 + (lane >> 5)) * t.N + (nok ? ncol : 0);
#pragma unroll
    for (int i = 0; i < 32; ++i) v[i] = W[(size_t)(2 * i) * t.N];
    if (!nok) {
#pragma unroll
        for (int i = 0; i < 32; ++i) v[i] = 0.f;
    }
}
__device__ __forceinline__ void conv_store(const ConvTask& t, LAS float* scr, int item, int lane, const float (&v)[32]) {
    const int nblk = (t.N + 31) / 32, kblk = t.K / 64, per = nblk * kblk;
    const int batch = item / per, r = item % per, kb = r / nblk, nb = r % nblk, k0 = 64 * kb, n0 = 32 * nb;
#pragma unroll
    for (int i = 0; i < 32; ++i) scr[(2 * i + (lane >> 5)) * 33 + (lane & 31)] = v[i];
    LDS_WAIT(); asm volatile("" ::: "memory");
    const int c = lane & 7;
    if (t.pad) {
#pragma unroll
        for (int j = 0; j < 4; ++j) { const int n = (lane >> 3) + 8 * j; const LAS float* s = scr + (8 * c) * 33 + n;
            const unsigned w0 = pk4_fp8(s[0 * 33] * 64.f, s[1 * 33] * 64.f, s[2 * 33] * 64.f, s[3 * 33] * 64.f), w1 = pk4_fp8(s[4 * 33] * 64.f, s[5 * 33] * 64.f, s[6 * 33] * 64.f, s[7 * 33] * 64.f);
            if (n0 + n < t.N) { const int dr = conv_rowmap(t.kind, t.p0, t.N, batch, n0 + n);
                u32x2 o; o.x = w0; o.y = w1; *(u32x2*)((unsigned char*)t.WT + (size_t)dr * t.ldwt + k0 + 8 * c) = o; } }
    } else {
#pragma unroll
    for (int j = 0; j < 4; ++j) { const int n = (lane >> 3) + 8 * j; const LAS float* s = scr + (8 * c) * 33 + n;
        u32x4 o; o.x = pk2(s[0 * 33], s[1 * 33]); o.y = pk2(s[2 * 33], s[3 * 33]); o.z = pk2(s[4 * 33], s[5 * 33]); o.w = pk2(s[6 * 33], s[7 * 33]);
        if (n0 + n < t.N) { const int dr = conv_rowmap(t.kind, t.p0, t.N, batch, n0 + n);
            *(u32x4*)(t.WT + (size_t)dr * t.ldwt + k0 + 8 * c) = o; } }
    }
    LDS_WAIT(); asm volatile("" ::: "memory");
}
__device__ __forceinline__ void conv_mk(ConvTask& t, const float* W, long wstride, int K, int N, int nbatch, bf16_t* WT, int ldwt, int kind, int p0, int fp8 = 0) {
    t.W = W; t.WT = WT; t.wstride = wstride; t.K = K; t.N = N; t.nbatch = nbatch; t.ldwt = ldwt; t.kind = kind; t.p0 = p0;
    t.nitems = nbatch * (K / 64) * ((N + 31) / 32); t.pad = fp8;
}
__device__ __forceinline__ bool conv_task(const Frame& F, unsigned char* wb, int l, int ti, ConvTask& t) {
    const size_t EW = (size_t)NEXP * D * EFF;
    switch (ti) {
    case 0: conv_mk(t, ain_g(F, IN_EG) + (size_t)l * EW, (long)D * EFF, D, EFF, NEXP, (bf16_t*)(wb + W_EGU), D, 2, 0, 1); return true;
    case 1: conv_mk(t, ain_g(F, IN_EU) + (size_t)l * EW, (long)D * EFF, D, EFF, NEXP, (bf16_t*)(wb + W_EGU), D, 2, 8, 1); return true;
    case 2: conv_mk(t, ain_g(F, IN_SG) + (size_t)l * D * EFF, 0, D, EFF, 1, (bf16_t*)(wb + W_EGU), D, 2, (64 << 16) | 0, 1); return true;
    case 3: conv_mk(t, ain_g(F, IN_SU) + (size_t)l * D * EFF, 0, D, EFF, 1, (bf16_t*)(wb + W_EGU), D, 2, (64 << 16) | 8, 1); return true;
    case 4: conv_mk(t, ain_g(F, IN_ED) + (size_t)l * EW, (long)EFF * D, EFF, D, NEXP, (bf16_t*)(wb + W_EDN), EFF, 0, 0, 1); return true;
    case 5: conv_mk(t, ain_g(F, IN_SD) + (size_t)l * EFF * D, 0, EFF, D, 1, (bf16_t*)(wb + W_EDN), EFF, 0, NEXP * D, 1); return true;
    case 6: conv_mk(t, ain_g(F, IN_ROUTER) + (size_t)l * D * NEXP, 0, D, NEXP, 1, (bf16_t*)(wb + W_ROUTER), D, 0, 0); return true;
    case 7: conv_mk(t, ain_g(F, IN_PLEG) + (size_t)l * D * D, 0, D, D, 1, (bf16_t*)(wb + W_PLEG), D, 0, 0, 1); return true;
    case 8: conv_mk(t, ain_g(F, IN_PLEW) + (size_t)l * 256 * D, 0, 256, D, 1, (bf16_t*)(wb + W_PLEW), 256, 0, 0); return true;
    case 9:
        if (l == 0) conv_mk(t, ain_g(F, IN_MW_IN), 0, D, 3088, 1, (bf16_t*)(wb + W_MIXIN), D, 0, 0);
        else if (l == 1) conv_mk(t, ain_g(F, IN_NW_IN), 0, D, 2608, 1, (bf16_t*)(wb + W_MIXIN), D, 3, 0, 1);
        else if (l == 2) conv_mk(t, ain_g(F, IN_DW_IN), 0, D, 7168, 1, (bf16_t*)(wb + W_MIXIN), D, 4, 0, 1);
        else conv_mk(t, ain_g(F, IN_POOLW), (long)256 * 256, 256, 256, 4, (bf16_t*)(wb + W_MIXOUT), 256, 0, 0);
        return true;
    case 10:
        if (l == 3) return false;
        conv_mk(t, l == 0 ? ain_g(F, IN_MW_OUT) : (l == 1 ? ain_g(F, IN_NW_OUT) : ain_g(F, IN_DW_OUT)), 0, D, D, 1, (bf16_t*)(wb + W_MIXOUT), D, 0, 0, l == 0 ? 0 : 1); return true;
    case 11: if (l != 1) return false; conv_mk(t, ain_g(F, IN_NWK), 0, 2048, 64, 1, (bf16_t*)(wb + W_CMPK), 2048, 0, 0); return true;
    case 12: if (l != 1) return false; conv_mk(t, ain_g(F, IN_NWV), 0, 2048, 64, 1, (bf16_t*)(wb + W_CMPV), 2048, 0, 0); return true;
    default: return false;
    }
}

constexpr unsigned CONV_MASK_LATE = 0xBFu, CONV_MASK_EARLY = 0x1F40u, CONV_MASK_ALL = 0x1FFFu;
__device__ __forceinline__ void phase_convert(Frame& F, const Args& args, int l, unsigned mask, int wi, int NW, bool extras) {
    unsigned char* wb = (unsigned char*)(F.ws + WS_W);
    LAS float* scr = (LAS float*)(F.lds + RING_OFF + F.wave * 16384);
    const int gw = wi * NWAVES + F.wave, NGW = NW * NWAVES;
    int total = 0;
    for (int ti = 0; ti < 13; ++ti) { ConvTask t; if (!conv_task(F, wb, l, ti, t)) break; if ((mask >> ti) & 1u) total += t.nitems; }
    auto decode = [&](int it, ConvTask& t, int& r) -> bool {
        if (it >= total) return false;
        r = it;
        for (int ti = 0; ti < 13; ++ti) { if (!conv_task(F, wb, l, ti, t)) return false; if (!((mask >> ti) & 1u)) continue; if (r < t.nitems) return true; r -= t.nitems; }
        return false;
    };
    {
        int it = gw; ConvTask tc; int rc = 0; bool have = decode(it, tc, rc);
        float cur[32];
        if (have) conv_load(tc, rc, F.lane, cur);
        while (have) {
            const int itn = it + NGW; ConvTask tn; int rn = 0; const bool hn = decode(itn, tn, rn);
            float nxt[32];
            if (hn) conv_load(tn, rn, F.lane, nxt);
            conv_store(tc, scr, rc, F.lane, cur);
            if (hn) {
#pragma unroll
                for (int i = 0; i < 32; ++i) cur[i] = nxt[i];
                tc = tn; rc = rn; }
            have = hn; it = itn;
        }
    }
    if (!extras) return;
    {
        const f32x4* src = (const f32x4*)(ain_g(F, IN_P) + (size_t)l * T * 256);
        u32x2* dst = (u32x2*)(F.ws + WS_PBF);
        const size_t nq = (size_t)T * 256 / 4;
        const size_t st = (size_t)NW * NTHREADS;
        for (size_t i = (size_t)wi * NTHREADS + F.tid; i < nq; i += 4 * st) {
            f32x4 v[4];
#pragma unroll
            for (int u = 0; u < 4; ++u) if (i + u * st < nq) v[u] = src[i + u * st];
#pragma unroll
            for (int u = 0; u < 4; ++u) if (i + u * st < nq) { u32x2 o; o.x = pk2(v[u].x, v[u].y); o.y = pk2(v[u].z, v[u].w); dst[i + u * st] = o; }
        }
    }
    if (l == 0) {
        const f32x4* src = (const f32x4*)ain_g(F, IN_X); u32x2* d16 = (u32x2*)(F.ws + WS_XB0); unsigned* d8 = (unsigned*)(F.ws + WS_X8A);
        const size_t nq = (size_t)T * D / 4;
        const size_t st = (size_t)NW * NTHREADS;
        for (size_t i = (size_t)wi * NTHREADS + F.tid; i < nq; i += 4 * st) {
            f32x4 v[4];
#pragma unroll
            for (int u = 0; u < 4; ++u) if (i + u * st < nq) v[u] = src[i + u * st];
#pragma unroll
            for (int u = 0; u < 4; ++u) if (i + u * st < nq) { u32x2 o; o.x = pk2(v[u].x, v[u].y); o.y = pk2(v[u].z, v[u].w); d16[i + u * st] = o; d8[i + u * st] = pk4_fp8(v[u].x, v[u].y, v[u].z, v[u].w); }
        }
        float* tc = (float*)(F.ws + WS_ROPE); float* tsn = tc + SEQ * 32;
        for (int i = wi * NTHREADS + F.tid; i < SEQ * 32; i += NW * NTHREADS) {
            const int pos = i >> 5, fi = i & 31;
            const float inv = fast_exp2(-(float)fi * (13.287712379549449f / 32.0f));
            const float ang = (float)pos * inv;
            const double rev = (double)ang * 0.15915494309189535; const float fr = (float)(rev - __builtin_rint(rev));
            const float sn = __builtin_amdgcn_sinf(fr), cs = __builtin_amdgcn_cosf(fr);
            tc[i] = cs; tsn[i] = sn;
        }
    }
    if (l == 1 && gw < 128) {
        const int which = gw >> 6, e = gw & 63;
        const float* pe = which ? ain_g(F, IN_NPOSV) : ain_g(F, IN_NPOSK); const float* w = which ? ain_g(F, IN_NWV) : ain_g(F, IN_NWK);
        float s = 0.f;
#pragma unroll
        for (int i = 0; i < 32; ++i) { const int k = 64 * i + F.lane; s += pe[k] * w[(size_t)k * 64 + e]; }
        s = wave_sum(s);
        if (F.lane == 0) ((float*)(F.ws + WS_W + W_CMPB))[which * 64 + e] = s;
    }
}

#define EPI_V(acc, ai, m, j) (acc[ai][(j) >> 3][m][((j) >> 2) & 1][(j) & 3])
constexpr float YM_SCALE = 16.0f, YM_INV = 1.0f / 16.0f;
struct EpiBf16 {
    bf16_t* O; int ldc; const float* colscale; unsigned char* O8;
    __device__ __forceinline__ int nv(const pg8::Unit&) const { return 16; }
    __device__ __forceinline__ void operator()(const f32x4 (&acc)[2][2][4][2], const pg8::Unit& u, int wr, int wc, int fr, int fq) const {
        const int row0 = u.pm * 256 + wr * 64 + fr, col0 = u.pn * 256 + wc * 64 + 16 * fq;
        float sc[16];
#pragma unroll
        for (int j = 0; j < 16; ++j) sc[j] = colscale ? colscale[col0 + j] : 1.0f;
#pragma unroll
        for (int ai = 0; ai < 2; ++ai)
#pragma unroll
            for (int m = 0; m < 4; ++m) { bf16_t* rowp = O + (size_t)(row0 + ai * 128 + m * 16) * ldc + col0;
                if (O8) { u32x4 w8;
#pragma unroll
                    for (int q = 0; q < 4; ++q) w8[q] = pk4_fp8(EPI_V(acc, ai, m, 4 * q) * sc[4 * q] * YM_SCALE, EPI_V(acc, ai, m, 4 * q + 1) * sc[4 * q + 1] * YM_SCALE, EPI_V(acc, ai, m, 4 * q + 2) * sc[4 * q + 2] * YM_SCALE, EPI_V(acc, ai, m, 4 * q + 3) * sc[4 * q + 3] * YM_SCALE);
                    *(u32x4*)(O8 + (size_t)(row0 + ai * 128 + m * 16) * ldc + col0) = w8; continue; }
                u32x4 w0, w1;
#pragma unroll
                for (int q = 0; q < 4; ++q) { w0[q] = cvt_pk_bf16(EPI_V(acc, ai, m, 2 * q) * sc[2 * q], EPI_V(acc, ai, m, 2 * q + 1) * sc[2 * q + 1]);
                    w1[q] = cvt_pk_bf16(EPI_V(acc, ai, m, 8 + 2 * q) * sc[8 + 2 * q], EPI_V(acc, ai, m, 9 + 2 * q) * sc[9 + 2 * q]); }
                *(u32x4*)rowp = w0; *(u32x4*)(rowp + 8) = w1; }
    }
};

constexpr float Y8_SCALE = 32.0f, Y8_INV = 1.0f / 32.0f;
struct EpiY8 {
    unsigned char* Y; int ldc;
#ifdef PROBE_Y8
    int hot;
#endif
    __device__ __forceinline__ int nv(const pg8::Unit&) const { return 8; }
    __device__ __forceinline__ void operator()(const f32x4 (&acc)[2][2][4][2], const pg8::Unit& u, int wr, int wc, int fr, int fq) const {
#ifdef PROBE_Y8
        if (hot == 3) return;
        const int row0 = (hot == 1 ? (u.pm & 63) * 256 : u.pm * 256) + wr * 64 + fr, col0 = u.pn * 256 + wc * 64 + 16 * fq;
#else
        const int row0 = u.pm * 256 + wr * 64 + fr, col0 = u.pn * 256 + wc * 64 + 16 * fq;
#endif
#pragma unroll
        for (int ai = 0; ai < 2; ++ai)
#pragma unroll
            for (int m = 0; m < 4; ++m) { unsigned char* rowp = Y + (size_t)(row0 + ai * 128 + m * 16) * ldc + col0;
                u32x4 st;
#pragma unroll
                for (int q = 0; q < 4; ++q) st[q] = pk4_fp8(EPI_V(acc, ai, m, 4 * q) * Y8_SCALE, EPI_V(acc, ai, m, 4 * q + 1) * Y8_SCALE, EPI_V(acc, ai, m, 4 * q + 2) * Y8_SCALE, EPI_V(acc, ai, m, 4 * q + 3) * Y8_SCALE);
#ifdef PROBE_Y8
                if (hot == 2) { asm volatile("" :: "v"(st)); } else
                if (hot == 4) { *(u32x4*)(Y + (size_t)((u.pm * 4 + u.pn) & 2047) * 65536 + ((wr * 4 + wc) * 8 + ai * 4 + m) * 1024 + (fr >> 1) * 128 + ((fr & 1) * 4 + fq) * 16) = st; } else
#endif
                *(u32x4*)rowp = st; }
    }
};

struct EpiProj {
    bf16_t* O; int ldc; int kind;
    float* gates; int ngate; int gate_pn;
    const float* rc; const float* rs;
    unsigned char* O8;
    __device__ __forceinline__ int nv(const pg8::Unit& u) const { return mode(u.pn) == 2 ? 0 : (O8 ? 8 : 16); }
    __device__ __forceinline__ int mode(int pn) const {
        if (kind == 0) return pn == 12 ? 2 : 0;
        if (kind == 1) return pn == 10 ? 2 : ((pn < 4 || pn == 6 || pn == 8) ? 1 : 0);
        return pn < 24 ? 1 : 0;
    }
    __device__ __forceinline__ void operator()(const f32x4 (&acc)[2][2][4][2], const pg8::Unit& u, int wr, int wc, int fr, int fq) const {
        const int row0 = u.pm * 256 + wr * 64 + fr, col0 = u.pn * 256 + wc * 64 + 16 * fq;
        const int md = mode(u.pn);
        if (md == 2) {
            const int c = wc * 64 + 16 * fq;
            if (c < ngate) {
#pragma unroll
                for (int ai = 0; ai < 2; ++ai)
#pragma unroll
                    for (int m = 0; m < 4; ++m) { float* gp = gates + (size_t)(row0 + ai * 128 + m * 16) * ngate + c;
#pragma unroll
                        for (int q = 0; q < 4; ++q) *(f32x4*)(gp + 4 * q) = (f32x4){EPI_V(acc, ai, m, 4 * q), EPI_V(acc, ai, m, 4 * q + 1), EPI_V(acc, ai, m, 4 * q + 2), EPI_V(acc, ai, m, 4 * q + 3)}; }
            }
        } else if (md == 1) {
#pragma unroll
            for (int ai = 0; ai < 2; ++ai)
#pragma unroll
                for (int m = 0; m < 4; ++m) { const int row = row0 + ai * 128 + m * 16; const int pos = row & (SEQ - 1);
                    const f32x4 c0 = *(const f32x4*)(rc + pos * 32 + 8 * fq), c1 = *(const f32x4*)(rc + pos * 32 + 8 * fq + 4), s0 = *(const f32x4*)(rs + pos * 32 + 8 * fq), s1 = *(const f32x4*)(rs + pos * 32 + 8 * fq + 4);
                    bf16_t* rowp = O + (size_t)row * ldc + col0;
                    float lo[8], hi[8];
#pragma unroll
                    for (int j = 0; j < 8; ++j) { const float x0 = EPI_V(acc, ai, m, j), x1 = EPI_V(acc, ai, m, 8 + j); const float cs = j < 4 ? c0[j] : c1[j - 4], sn = j < 4 ? s0[j] : s1[j - 4];
                        lo[j] = x0 * cs - x1 * sn; hi[j] = x0 * sn + x1 * cs; }
                    if (O8) { u32x4 w8; w8[0] = pk4_fp8(lo[0], lo[1], lo[2], lo[3]); w8[1] = pk4_fp8(lo[4], lo[5], lo[6], lo[7]); w8[2] = pk4_fp8(hi[0], hi[1], hi[2], hi[3]); w8[3] = pk4_fp8(hi[4], hi[5], hi[6], hi[7]);
                        *(u32x4*)(O8 + (size_t)row * ldc + col0) = w8; }
                    else { u32x4 w0, w1;
#pragma unroll
                        for (int q = 0; q < 4; ++q) { w0[q] = cvt_pk_bf16(lo[2 * q], lo[2 * q + 1]); w1[q] = cvt_pk_bf16(hi[2 * q], hi[2 * q + 1]); }
                        *(u32x4*)rowp = w0; *(u32x4*)(rowp + 8) = w1; } }
        } else {
#pragma unroll
            for (int ai = 0; ai < 2; ++ai)
#pragma unroll
                for (int m = 0; m < 4; ++m) { bf16_t* rowp = O + (size_t)(row0 + ai * 128 + m * 16) * ldc + col0;
                    if (O8) { u32x4 w8;
#pragma unroll
                        for (int q = 0; q < 4; ++q) w8[q] = pk4_fp8(EPI_V(acc, ai, m, 4 * q), EPI_V(acc, ai, m, 4 * q + 1), EPI_V(acc, ai, m, 4 * q + 2), EPI_V(acc, ai, m, 4 * q + 3));
                        *(u32x4*)(O8 + (size_t)(row0 + ai * 128 + m * 16) * ldc + col0) = w8; }
                    else { u32x4 w0, w1;
#pragma unroll
                        for (int q = 0; q < 4; ++q) { w0[q] = cvt_pk_bf16(EPI_V(acc, ai, m, 2 * q), EPI_V(acc, ai, m, 2 * q + 1)); w1[q] = cvt_pk_bf16(EPI_V(acc, ai, m, 8 + 2 * q), EPI_V(acc, ai, m, 9 + 2 * q)); }
                        *(u32x4*)rowp = w0; *(u32x4*)(rowp + 8) = w1; } }
        }
    }
};

struct EpiSwiGLU {
    unsigned char* H;
    __device__ __forceinline__ int nv(const pg8::Unit&) const { return 8; }
    __device__ __forceinline__ void operator()(const f32x4 (&acc)[2][2][4][2], const pg8::Unit& u, int wr, int wc, int fr, int fq) const {
        const int row0 = u.pm * 256 + wr * 64 + fr, col0 = u.pn * 128 + wc * 32 + 8 * fq;
#pragma unroll
        for (int ai = 0; ai < 2; ++ai)
#pragma unroll
            for (int m = 0; m < 4; ++m) { unsigned char* rowp = H + (size_t)(row0 + ai * 128 + m * 16) * EFF + col0;
                float r[8];
#pragma unroll
                for (int j = 0; j < 8; ++j) { const float g = EPI_V(acc, ai, m, j), up = EPI_V(acc, ai, m, 8 + j); r[j] = g * sigmoidf_(g) * up; }
                u32x2 st; st.x = pk4_fp8(r[0], r[1], r[2], r[3]); st.y = pk4_fp8(r[4], r[5], r[6], r[7]); *(u32x2*)rowp = st; }
    }
};

struct EpiRouter {
    float* L;
    __device__ __forceinline__ int nv(const pg8::Unit&) const { return 0; }
    __device__ __forceinline__ void operator()(const f32x4 (&acc)[2][2][4][2], const pg8::Unit& u, int wr, int wc, int fr, int fq) const {
        if (wc != 0) return;
        const int row0 = u.pm * 256 + wr * 64 + fr, c = 16 * fq;
#pragma unroll
        for (int ai = 0; ai < 2; ++ai)
#pragma unroll
            for (int m = 0; m < 4; ++m) { float* p = L + (size_t)(row0 + ai * 128 + m * 16) * 64 + c;
#pragma unroll
                for (int q = 0; q < 4; ++q) *(f32x4*)(p + 4 * q) = (f32x4){EPI_V(acc, ai, m, 4 * q), EPI_V(acc, ai, m, 4 * q + 1), EPI_V(acc, ai, m, 4 * q + 2), EPI_V(acc, ai, m, 4 * q + 3)}; }
    }
};

struct EpiPLE {
    const bf16_t* X2; const unsigned char* PW; bf16_t* XB; float* XF; unsigned char* X8;
    __device__ __forceinline__ int nv(const pg8::Unit&) const { return 16; }
    __device__ __forceinline__ void operator()(const f32x4 (&acc)[2][2][4][2], const pg8::Unit& u, int wr, int wc, int fr, int fq) const {
        const int row0 = u.pm * 256 + wr * 64 + fr, col0 = u.pn * 256 + wc * 64 + 16 * fq;
#pragma unroll
        for (int ai = 0; ai < 2; ++ai)
#pragma unroll
            for (int m = 0; m < 4; ++m) { const size_t o = (size_t)(row0 + ai * 128 + m * 16) * D + col0;
                const u32x4 xa = *(const u32x4*)(X2 + o), xb2 = *(const u32x4*)(X2 + o + 8), p8 = *(const u32x4*)(PW + o);
                float r[16], pvv[16];
#pragma unroll
                for (int q = 0; q < 4; ++q) { const f32x2 plo = __builtin_amdgcn_cvt_pk_f32_fp8((int)p8[q], false), phi = __builtin_amdgcn_cvt_pk_f32_fp8((int)p8[q], true);
                    pvv[4 * q] = plo.x; pvv[4 * q + 1] = plo.y; pvv[4 * q + 2] = phi.x; pvv[4 * q + 3] = phi.y; }
#pragma unroll
                for (int j = 0; j < 16; ++j) { const unsigned xw = j < 8 ? xa[j >> 1] : xb2[(j - 8) >> 1];
                    const float xv = (j & 1) ? bfhi(xw) : bflo(xw);
                    r[j] = xv + sigmoidf_(EPI_V(acc, ai, m, j)) * pvv[j]; }
                if (XF) {
#pragma unroll
                    for (int q = 0; q < 4; ++q) *(f32x4*)(XF + o + 4 * q) = (f32x4){r[4 * q], r[4 * q + 1], r[4 * q + 2], r[4 * q + 3]}; }
                u32x4 w0, w1, w8;
#pragma unroll
                for (int q = 0; q < 4; ++q) { w0[q] = cvt_pk_bf16(r[2 * q], r[2 * q + 1]); w1[q] = cvt_pk_bf16(r[8 + 2 * q], r[9 + 2 * q]); w8[q] = pk4_fp8(r[4 * q], r[4 * q + 1], r[4 * q + 2], r[4 * q + 3]); }
                *(u32x4*)(XB + o) = w0; *(u32x4*)(XB + o + 8) = w1; *(u32x4*)(X8 + o) = w8; }
    }
};

__device__ __forceinline__ void ln_acc_bf16(float (&v)[16], const bf16_t* row, float w, int lane) {
    const u32x4 a = *(const u32x4*)(row + 16 * lane), b = *(const u32x4*)(row + 16 * lane + 8);
    v[0] += w * bflo(a.x); v[1] += w * bfhi(a.x); v[2] += w * bflo(a.y); v[3] += w * bfhi(a.y); v[4] += w * bflo(a.z); v[5] += w * bfhi(a.z); v[6] += w * bflo(a.w); v[7] += w * bfhi(a.w);
    v[8] += w * bflo(b.x); v[9] += w * bfhi(b.x); v[10] += w * bflo(b.y); v[11] += w * bfhi(b.y); v[12] += w * bflo(b.z); v[13] += w * bfhi(b.z); v[14] += w * bflo(b.w); v[15] += w * bfhi(b.w);
}
__device__ __forceinline__ void ln_acc_fp8(float (&v)[16], const unsigned char* row, float w, int lane) {
    const u32x4 a = *(const u32x4*)(row + 16 * lane);
#pragma unroll
    for (int q = 0; q < 4; ++q) { const f32x2 lo = __builtin_amdgcn_cvt_pk_f32_fp8((int)a[q], false), hi = __builtin_amdgcn_cvt_pk_f32_fp8((int)a[q], true);
        v[4 * q] += w * lo.x; v[4 * q + 1] += w * lo.y; v[4 * q + 2] += w * hi.x; v[4 * q + 3] += w * hi.y; }
}
template <int MODE>
__device__ __forceinline__ void phase_ln(Frame& F, const bf16_t* Xin, const void* Ysrc, const float* g, const float* b, bf16_t* XB,
                                         const int* posk, const float* gwt, int shbase, unsigned char* X8 = nullptr) {
    const int gw = F.vcu * NWAVES + F.wave, NGW = F.G * NWAVES, lane = F.lane;
    f32x4 gg[4], bb[4];
#pragma unroll
    for (int j = 0; j < 4; ++j) { gg[j] = *(const f32x4*)(g + 16 * lane + 4 * j); bb[j] = *(const f32x4*)(b + 16 * lane + 4 * j); }
    int pkn = 0; float wkn = 0.f;
    if (MODE == 2 && gw < T && lane < 8) { pkn = posk[(size_t)gw * 8 + lane]; wkn = gwt[(size_t)gw * 8 + lane]; }
    for (int row = gw; row < T; row += NGW) {
        float v[16];
#pragma unroll
        for (int i = 0; i < 16; ++i) v[i] = 0.f;
        int pk = pkn; float wk = wkn * Y8_INV;
        if (MODE == 2 && row + NGW < T && lane < 8) { pkn = posk[(size_t)(row + NGW) * 8 + lane]; wkn = gwt[(size_t)(row + NGW) * 8 + lane]; }
        ln_acc_bf16(v, Xin + (size_t)row * D, ALPHA, lane);
        if (MODE == 1) ln_acc_fp8(v, (const unsigned char*)Ysrc + (size_t)row * D, YM_INV, lane);
        else if (MODE == 2) {
#pragma unroll
            for (int k = 0; k < 9; ++k) {
                const int p = (k < 8) ? __shfl(pk, k) : (shbase + row); const float w8 = (k < 8) ? __shfl(wk, k) : Y8_INV;
                ln_acc_fp8(v, (const unsigned char*)Ysrc + (size_t)p * D, w8, lane);
            }
        }
        float s = 0.f;
#pragma unroll
        for (int i = 0; i < 16; ++i) s += v[i];
        const float mean = wave_sum(s) * (1.f / D); float s2 = 0.f;
#pragma unroll
        for (int i = 0; i < 16; ++i) { v[i] -= mean; s2 += v[i] * v[i]; }
        const float rstd = frsq(wave_sum(s2) * (1.f / D) + LN_EPS);
        u32x4 o0, o1, o8;
#pragma unroll
        for (int q = 0; q < 4; ++q) { const float a0 = v[4 * q] * rstd * gg[q][0] + bb[q][0], a1 = v[4 * q + 1] * rstd * gg[q][1] + bb[q][1], a2 = v[4 * q + 2] * rstd * gg[q][2] + bb[q][2], a3 = v[4 * q + 3] * rstd * gg[q][3] + bb[q][3];
            const unsigned w0 = cvt_pk_bf16(a0, a1), w1 = cvt_pk_bf16(a2, a3); o8[q] = pk4_fp8(a0, a1, a2, a3);
            if (q < 2) { o0[2 * q] = w0; o0[2 * q + 1] = w1; } else { o1[2 * (q - 2)] = w0; o1[2 * (q - 2) + 1] = w1; } }
        bf16_t* xbr = XB + (size_t)row * D + 16 * lane;
        *(u32x4*)xbr = o0; *(u32x4*)(xbr + 8) = o1;
        if (X8) *(u32x4*)(X8 + (size_t)row * D + 16 * lane) = o8;
    }
}

__device__ __forceinline__ void phase_route1(Frame& F, const float* logits, const float* rbias, int* eidx, float* gwt, int* lrank, int* blk_hist) {
    LAS int* hist = (LAS int*)(F.lds + RING_OFF);
    const int lane = F.lane;
    const float bias = rbias[lane];
    for (int chunk = blockIdx.x; chunk < T / 128; chunk += F.G) {
        if (F.tid < 64) hist[F.tid] = 0;
        __syncthreads();
        for (int i0 = 0; i0 < 16; i0 += 4) {
            float score[4], val[4]; int tk[4];
#pragma unroll
            for (int u = 0; u < 4; ++u) {
                const int t = chunk * 128 + F.wave * 16 + i0 + u; tk[u] = t;
                const float lg = logits[(size_t)t * 64 + lane];
                score[u] = fast_rcp(1.0f + fexp(-lg));
            }
#pragma unroll
            for (int u = 0; u < 4; ++u) {
                const float biased = score[u] + bias;
                const float m1 = group8_max_dpp(biased, lane);
                const unsigned long long bm = __ballot(biased == m1);
                const int grp = lane >> 3;
                const unsigned gb = (unsigned)((bm >> (8 * grp)) & 0xffull);
                const int firstmax = 8 * grp + (__ffs((int)gb) - 1);
                const float m2 = group8_max_dpp((lane == firstmax) ? -3.0e38f : biased, lane);
                const float gs = m1 + m2;
                int cnt = 0;
#pragma unroll
                for (int g2 = 0; g2 < 8; ++g2) { const float sc = __builtin_bit_cast(float, __builtin_amdgcn_readlane(__builtin_bit_cast(int, gs), 8 * g2)); cnt += (sc > gs || (sc == gs && g2 < grp)) ? 1 : 0; }
                val[u] = (cnt < 4) ? biased : NEG_BIG;
            }
            bool taken[4]; int myk[4];
#pragma unroll
            for (int u = 0; u < 4; ++u) { taken[u] = false; myk[u] = 0; }
#pragma unroll
            for (int k = 0; k < 8; ++k) {
#pragma unroll
                for (int u = 0; u < 4; ++u) {
                    const float cand = taken[u] ? -3.0e38f : val[u];
                    const float mx = wave_max_dpp(cand);
                    const unsigned long long bal = __ballot(cand == mx);
                    const int win = __ffsll((long long)bal) - 1;
                    if (lane == win) { taken[u] = true; myk[u] = k; }
                }
            }
#pragma unroll
            for (int u = 0; u < 4; ++u) {
                const float sw = wave_sum_dpp(taken[u] ? score[u] : 0.f);
                if (taken[u]) {
                    const int lr = __hip_atomic_fetch_add(hist + lane, 1, __ATOMIC_RELAXED, __HIP_MEMORY_SCOPE_WORKGROUP);
                    const size_t o = (size_t)tk[u] * 8 + myk[u];
                    eidx[o] = lane; gwt[o] = score[u] * fast_rcp(sw) * 2.5f; lrank[o] = lr;
                }
            }
        }
        __syncthreads();
        if (F.tid < 64) blk_hist[chunk * 64 + F.tid] = hist[F.tid];
        __syncthreads();
    }
}
__device__ __forceinline__ void phase_route2(Frame& F, const int* eidx, const int* lrank, const int* blk_hist, int* posk, int* row_token, int* tile_e, int* meta) {
    LAS int* cnt = (LAS int*)(F.lds + RING_OFF); LAS int* base = cnt + 64; LAS int* off = cnt + 128;
    LAS int* pc_ = cnt + 256; LAS int* pb_ = cnt + 768;
    for (int chunk = blockIdx.x; chunk < T / 128; chunk += F.G) {
        __syncthreads();
        { const int e = F.tid & 63, part = F.tid >> 6; int c = 0, bs = 0;
#pragma unroll 8
          for (int i = 0; i < 32; ++i) { const int b2 = 32 * part + i; const int h = blk_hist[b2 * 64 + e]; c += h; bs += (b2 < chunk) ? h : 0; }
          pc_[part * 64 + e] = c; pb_[part * 64 + e] = bs; }
        __syncthreads();
        if (F.tid < 64) { int c = 0, bs = 0;
#pragma unroll
          for (int q = 0; q < 8; ++q) { c += pc_[q * 64 + F.tid]; bs += pb_[q * 64 + F.tid]; }
          cnt[F.tid] = c; base[F.tid] = bs; }
        __syncthreads();
        if (F.tid == 0) { int o = 0; for (int e = 0; e < 64; ++e) { off[e] = o; o += (cnt[e] + 255) & ~255; } off[64] = o; }
        __syncthreads();
        for (int a = F.tid; a < 128 * 8; a += NTHREADS) {
            const size_t ga = (size_t)chunk * 1024 + a; const int e = eidx[ga]; const int pos = off[e] + base[e] + lrank[ga];
            posk[ga] = pos; row_token[pos] = (int)(ga >> 3);
        }
        if (F.tid < 128) row_token[off[64] + chunk * 128 + F.tid] = chunk * 128 + F.tid;
        if (chunk < 64) {
            const int e = chunk;
            for (int r = off[e] + cnt[e] + F.tid; r < off[e + 1]; r += NTHREADS) row_token[r] = 0;
            for (int tl = off[e] / 256 + F.tid; tl < off[e + 1] / 256; tl += NTHREADS) tile_e[tl] = e;
        } else if (chunk == 64) {
            if (F.tid < 128) tile_e[off[64] / 256 + F.tid] = 64;
            if (F.tid == 0) { meta[0] = off[64]; meta[1] = off[64] / 256 + T / 256; }
        }
    }
    __syncthreads();
}


__device__ __forceinline__ bf16x8 frag_row(const LAS unsigned char* base, int ldb, int r0, int k0, int lane) {
    return *(const LAS bf16x8*)(base + (r0 + (lane & 15)) * ldb + (k0 + 8 * (lane >> 4)) * 2);
}
__device__ __forceinline__ bf16x8 frag_tr(const LAS unsigned char* base, int ldb, int rowA, int rowB, int c0, int lane) {
    const int q = (lane & 15) >> 2, p = lane & 3;
    const unsigned a0 = (unsigned)(size_t)(base + (rowA + q) * ldb + (c0 + 4 * p) * 2);
    const unsigned a1 = (unsigned)(size_t)(base + (rowB + q) * ldb + (c0 + 4 * p) * 2);
    bf16x4 lo, hi;
    asm volatile("ds_read_b64_tr_b16 %0, %2\n\tds_read_b64_tr_b16 %1, %3\n\ts_waitcnt lgkmcnt(0)" : "=&v"(lo), "=&v"(hi) : "v"(a0), "v"(a1) : "memory");
    bf16x8 r; r[0] = lo[0]; r[1] = lo[1]; r[2] = lo[2]; r[3] = lo[3]; r[4] = hi[0]; r[5] = hi[1]; r[6] = hi[2]; r[7] = hi[3];
    return r;
}
__device__ __forceinline__ bf16x8 pack_bf16x8(const f32x4 a, const f32x4 b) {
    u32x4 w; w.x = cvt_pk_bf16(a[0], a[1]); w.y = cvt_pk_bf16(a[2], a[3]); w.z = cvt_pk_bf16(b[0], b[1]); w.w = cvt_pk_bf16(b[2], b[3]);
    return __builtin_bit_cast(bf16x8, w);
}
template <int LD>
__device__ __forceinline__ void frag_tr4(const LAS unsigned char* base, int rowA, int lane, bf16x8 (&out)[4]) {
    const int q = (lane & 15) >> 2, p = lane & 3;
    const unsigned a0 = (unsigned)(size_t)(base + (rowA + q) * LD + 8 * p);
    bf16x4 r0, r1, r2, r3, r4, r5, r6, r7;
    asm volatile("ds_read_b64_tr_b16 %0, %8\n\tds_read_b64_tr_b16 %1, %8 offset:%9\n\tds_read_b64_tr_b16 %2, %8 offset:32\n\tds_read_b64_tr_b16 %3, %8 offset:%10\n\t"
                 "ds_read_b64_tr_b16 %4, %8 offset:64\n\tds_read_b64_tr_b16 %5, %8 offset:%11\n\tds_read_b64_tr_b16 %6, %8 offset:96\n\tds_read_b64_tr_b16 %7, %8 offset:%12\n\ts_waitcnt lgkmcnt(0)"
                 : "=&v"(r0), "=&v"(r1), "=&v"(r2), "=&v"(r3), "=&v"(r4), "=&v"(r5), "=&v"(r6), "=&v"(r7)
                 : "v"(a0), "n"(16 * LD), "n"(16 * LD + 32), "n"(16 * LD + 64), "n"(16 * LD + 96) : "memory");
    out[0] = __builtin_shufflevector(r0, r1, 0, 1, 2, 3, 4, 5, 6, 7); out[1] = __builtin_shufflevector(r2, r3, 0, 1, 2, 3, 4, 5, 6, 7);
    out[2] = __builtin_shufflevector(r4, r5, 0, 1, 2, 3, 4, 5, 6, 7); out[3] = __builtin_shufflevector(r6, r7, 0, 1, 2, 3, 4, 5, 6, 7);
}
#define MFMA16(a, b, c) __builtin_amdgcn_mfma_f32_16x16x32_bf16(a, b, c, 0, 0, 0)
__device__ __forceinline__ float logsigmoidf_(float x) { return fminf(x, 0.f) - flog(1.0f + fexp(-fabsf(x))); }


constexpr int DLP = 7168, DL_LD = 144, DL_ROWS = 288;
constexpr float SM_C = 0.125f * 1.44269504f;
__device__ __forceinline__ bf16x8 fp8x8_to_bf16(unsigned a, unsigned b) {
    const f32x2 p0 = __builtin_amdgcn_cvt_pk_f32_fp8((int)a, false), p1 = __builtin_amdgcn_cvt_pk_f32_fp8((int)a, true), p2 = __builtin_amdgcn_cvt_pk_f32_fp8((int)b, false), p3 = __builtin_amdgcn_cvt_pk_f32_fp8((int)b, true);
    u32x4 w; w.x = cvt_pk_bf16(p0.x, p0.y); w.y = cvt_pk_bf16(p1.x, p1.y); w.z = cvt_pk_bf16(p2.x, p2.y); w.w = cvt_pk_bf16(p3.x, p3.y);
    return __builtin_bit_cast(bf16x8, w);
}
constexpr float OG_SCALE = 16.0f, OG_INV = 1.0f / 16.0f;
__device__ __forceinline__ void phase_dilated_attn(Frame& F, const unsigned char* proj, unsigned char* og0, unsigned char* og1, unsigned char* og2, float* lse) {
    LAS unsigned char* kt = F.lds + RING_OFF;
    LAS unsigned char* vt = F.lds + RING_OFF + DL_ROWS * DL_LD;
    const int lane = F.lane, w = F.wave, tid = F.tid, gq = lane >> 4, tq = lane & 15;
    unsigned zz = 0u; asm volatile("" : "+v"(zz));
    const u32x4 zero4 = (u32x4){zz, zz, zz, zz};
    for (int pc = tid; pc < 2 * 32 * 9; pc += NTHREADS) { const int tn = pc / (32 * 9), r = pc % (32 * 9);
        *(LAS u32x4*)(F.lds + RING_OFF + tn * DL_ROWS * DL_LD + 256 * DL_LD + r * 16) = zero4; }
    constexpr int NITEMS = 3 * NB * 16 * 32;
    u32x4 pre[4]; u32x2 qra, qrb; size_t qtok_n = 0;
    auto prefetch = [&](int item) {
        const int idx = (item >> 1) & 31, head = ((item >> 6) & 7) * 2 + (item & 1), b = (item >> 9) & 7, grp = item >> 12;
        const int dsh = 2 * grp, dil = 1 << dsh, r = idx & (dil - 1), jt = idx >> dsh;
        const unsigned char* pb = proj + (size_t)b * SEQ * DLP;
        const int qcol = 2 * grp * 1024 + head * 64, kcol = qcol + 1024, vcol = 6144 + head * 64;
#pragma unroll
        for (int i = 0; i < 4; ++i) { const int pc = tid + i * 512, tn = pc >> 10, rr = pc & 1023, j = rr >> 2, d16 = (rr & 3) * 16;
            const int ik = 128 * jt - 128 + j; u32x4 val = zero4;
            if (ik >= 0) val = *(const u32x4*)(pb + (size_t)((ik << dsh) + r) * DLP + (tn ? vcol : kcol) + d16);
            pre[i] = val; }
        const int iq = 16 * w + tq;
        qtok_n = (size_t)b * SEQ + (size_t)(((128 * jt + iq) << dsh) + r);
        qra = *(const u32x2*)(proj + qtok_n * DLP + qcol + 8 * gq); qrb = *(const u32x2*)(proj + qtok_n * DLP + qcol + 32 + 8 * gq);
    };
    if (F.vcu < NITEMS) prefetch(F.vcu);
    for (int item = F.vcu; item < NITEMS; item += F.G) {
        const int idx = (item >> 1) & 31, head = ((item >> 6) & 7) * 2 + (item & 1), grp = item >> 12;
        const int dsh = 2 * grp, jt = idx >> dsh;
        __syncthreads();
#pragma unroll
        for (int i = 0; i < 4; ++i) { const int pc = tid + i * 512, tn = pc >> 10, rr = pc & 1023, j = rr >> 2, d16 = (rr & 3) * 16;
            LAS unsigned char* dst = F.lds + RING_OFF + tn * DL_ROWS * DL_LD + j * DL_LD + d16 * 2;
            *(LAS bf16x8*)dst = fp8x8_to_bf16(pre[i].x, pre[i].y); *(LAS bf16x8*)(dst + 16) = fp8x8_to_bf16(pre[i].z, pre[i].w); }
        const int iq = 16 * w + tq;
        const size_t qtok = qtok_n; const bf16x8 qf0 = fp8x8_to_bf16(qra.x, qra.y), qf1 = fp8x8_to_bf16(qrb.x, qrb.y);
        __syncthreads();
        if (item + F.G < NITEMS) prefetch(item + F.G);
        f32x4 acc[4];
#pragma unroll
        for (int n = 0; n < 4; ++n) acc[n] = (f32x4){0.f, 0.f, 0.f, 0.f};
        float mrun = NEG_BIG, lrun = 0.f;
        auto qk = [&](int kb, f32x4 (&s)[2]) {
            const int j0 = 16 * w + 32 * kb;
#pragma unroll
            for (int h2 = 0; h2 < 2; ++h2) { f32x4 z = (f32x4){0.f, 0.f, 0.f, 0.f};
                z = MFMA16(frag_row(kt, DL_LD, j0 + 16 * h2, 0, lane), qf0, z);
                z = MFMA16(frag_row(kt, DL_LD, j0 + 16 * h2, 32, lane), qf1, z);
                s[h2] = z; }
        };
        f32x4 sn[2]; qk(0, sn);
#pragma unroll
        for (int kb = 0; kb < 5; ++kb) {
            const int j0 = 16 * w + 32 * kb;
            f32x4 s[2] = {sn[0], sn[1]};
            if (kb < 4) qk(kb + 1, sn);
            if (kb == 0 || kb == 4 || jt == 0) {
#pragma unroll
                for (int h2 = 0; h2 < 2; ++h2)
#pragma unroll
                    for (int rr = 0; rr < 4; ++rr) { const int j = j0 + 16 * h2 + 4 * gq + rr; const int dd = iq + 128 - j;
                        const bool ok = (dd >= 0) && (dd <= 128) && (128 * jt - 128 + j >= 0);
                        s[h2][rr] = ok ? s[h2][rr] : -3.0e38f; }
            }
            float mx = fmaxf(fmaxf(fmaxf(s[0][0], s[0][1]), fmaxf(s[0][2], s[0][3])), fmaxf(fmaxf(s[1][0], s[1][1]), fmaxf(s[1][2], s[1][3])));
            mx = fmaxf(mx * SM_C, NEG_BIG);
            if (__any(mx > mrun + 8.0f)) {
                mx = fmaxf(mx, __shfl_xor(mx, 16)); mx = fmaxf(mx, __shfl_xor(mx, 32));
                const float mnew = fmaxf(mrun, mx), alpha = fast_exp2(mrun - mnew);
                lrun *= alpha; mrun = mnew;
#pragma unroll
                for (int n = 0; n < 4; ++n) acc[n] = acc[n] * alpha;
            }
            const float negm = -mrun;
            float ps = 0.f;
#pragma unroll
            for (int h2 = 0; h2 < 2; ++h2)
#pragma unroll
                for (int rr = 0; rr < 4; ++rr) { const float pe = fast_exp2(__builtin_fmaf(s[h2][rr], SM_C, negm)); s[h2][rr] = pe; ps += pe; }
            lrun += ps;
            const bf16x8 pf = pack_bf16x8(s[0], s[1]);
            bf16x8 vf[4]; frag_tr4<DL_LD>(vt, j0 + 4 * gq, lane, vf);
#pragma unroll
            for (int n = 0; n < 4; ++n) acc[n] = MFMA16(vf[n], pf, acc[n]);
        }
        lrun += __shfl_xor(lrun, 16); lrun += __shfl_xor(lrun, 32);
        const float inv = fast_rcp(lrun) * OG_SCALE;
        unsigned char* og = grp == 0 ? og0 : (grp == 1 ? og1 : og2);
#pragma unroll
        for (int n = 0; n < 4; ++n) *(unsigned*)(og + qtok * D + head * 64 + 16 * n + 4 * gq) = pk4_fp8(acc[n][0] * inv, acc[n][1] * inv, acc[n][2] * inv, acc[n][3] * inv);
        if (gq == 0) lse[((size_t)grp * T + qtok) * 16 + head] = mrun * 0.69314718f + flog(lrun);
    }
    __syncthreads();
}
__device__ __forceinline__ void phase_dilated_combine(Frame& F, const unsigned char* og0, const unsigned char* og1, const unsigned char* og2, const float* lse, unsigned char* Out) {
#pragma unroll 2
    for (size_t i = (size_t)blockIdx.x * NTHREADS + F.tid; i < (size_t)T * 128; i += (size_t)F.G * NTHREADS) {
        const size_t tok = i >> 7; const int pc = (int)(i & 127), head = pc >> 3;
        const float l0 = lse[tok * 16 + head], l1 = lse[((size_t)T + tok) * 16 + head], l2 = lse[((size_t)2 * T + tok) * 16 + head];
        const float mx = fmaxf(l0, fmaxf(l1, l2));
        float w0 = fexp(l0 - mx), w1 = fexp(l1 - mx), w2 = fexp(l2 - mx); const float inv = fast_rcp(w0 + w1 + w2) * OG_INV; w0 *= inv; w1 *= inv; w2 *= inv;
        const u32x2 a = *(const u32x2*)(og0 + tok * D + pc * 8), bq = *(const u32x2*)(og1 + tok * D + pc * 8), c = *(const u32x2*)(og2 + tok * D + pc * 8);
        u32x2 o;
#pragma unroll
        for (int h = 0; h < 2; ++h) {
            const f32x2 a0 = __builtin_amdgcn_cvt_pk_f32_fp8((int)a[h], false), a1 = __builtin_amdgcn_cvt_pk_f32_fp8((int)a[h], true);
            const f32x2 b0 = __builtin_amdgcn_cvt_pk_f32_fp8((int)bq[h], false), b1 = __builtin_amdgcn_cvt_pk_f32_fp8((int)bq[h], true);
            const f32x2 c0 = __builtin_amdgcn_cvt_pk_f32_fp8((int)c[h], false), c1 = __builtin_amdgcn_cvt_pk_f32_fp8((int)c[h], true);
            o[h] = pk4_fp8(w0 * a0.x + w1 * b0.x + w2 * c0.x, w0 * a0.y + w1 * b0.y + w2 * c0.y, w0 * a1.x + w1 * b1.x + w2 * c1.x, w0 * a1.y + w1 * b1.y + w2 * c1.y); }
        *(u32x2*)(Out + tok * D + pc * 8) = o;
    }
}

constexpr int ML_LDQ = 144, ML_LDV = 272;
constexpr int MLP = 3072;
__device__ __forceinline__ void ml_conv_piece(const bf16_t* proj, const float* convw, int b, int c, int s, int colbase, int d8, float scale, LAS unsigned char* tile) {
    float acc[8];
#pragma unroll
    for (int i = 0; i < 8; ++i) acc[i] = 0.f;
#pragma unroll
    for (int j = 0; j < 4; ++j) {
        const int sp = 64 * c + s - 3 + j;
        if (sp >= 0) {
            const u32x4 x = *(const u32x4*)(proj + ((size_t)b * SEQ + sp) * MLP + colbase + d8);
            const f32x4 w0 = *(const f32x4*)(convw + j * 1024 + colbase + d8), w1 = *(const f32x4*)(convw + j * 1024 + colbase + d8 + 4);
            acc[0] += bflo(x.x) * w0[0]; acc[1] += bfhi(x.x) * w0[1]; acc[2] += bflo(x.y) * w0[2]; acc[3] += bfhi(x.y) * w0[3];
            acc[4] += bflo(x.z) * w1[0]; acc[5] += bfhi(x.z) * w1[1]; acc[6] += bflo(x.w) * w1[2]; acc[7] += bfhi(x.w) * w1[3];
        }
    }
#pragma unroll
    for (int i = 0; i < 8; ++i) acc[i] = acc[i] * sigmoidf_(acc[i]) * scale;
    u32x4 o; o.x = cvt_pk_bf16(acc[0], acc[1]); o.y = cvt_pk_bf16(acc[2], acc[3]); o.z = cvt_pk_bf16(acc[4], acc[5]); o.w = cvt_pk_bf16(acc[6], acc[7]);
    *(LAS u32x4*)(tile + s * ML_LDQ + d8 * 2) = o;
}
__device__ __forceinline__ void ml_gate_scan(const float* gates, const float* igb, const float* fgb, int b, int h, int c, int lane, float& bcum, float& a, float& g) {
    const size_t t = (size_t)b * SEQ + 64 * c + lane;
    const float ig = gates[t * 16 + h] + igb[h];
    const float lf = logsigmoidf_(gates[t * 16 + 8 + h] + fgb[h]);
    float v = lf;
#pragma unroll
    for (int o = 1; o < 64; o <<= 1) { const float u = __shfl_up(v, o); if (lane >= o) v += u; }
    bcum = v; a = ig - v;
    float m = a;
#pragma unroll
    for (int o = 1; o < 64; o <<= 1) { const float u = __shfl_up(m, o); if (lane >= o) m = fmaxf(m, u); }
    g = m;
}

__device__ __forceinline__ void ml_conv_piece_pre(const u32x4 (&x)[4], const float* convw, int s, int colbase, int d8, float scale, LAS unsigned char* tile) {
    float acc[8];
#pragma unroll
    for (int i = 0; i < 8; ++i) acc[i] = 0.f;
#pragma unroll
    for (int j = 0; j < 4; ++j) {
        const f32x4 w0 = *(const f32x4*)(convw + j * 1024 + colbase + d8), w1 = *(const f32x4*)(convw + j * 1024 + colbase + d8 + 4);
        acc[0] += bflo(x[j].x) * w0[0]; acc[1] += bfhi(x[j].x) * w0[1]; acc[2] += bflo(x[j].y) * w0[2]; acc[3] += bfhi(x[j].y) * w0[3];
        acc[4] += bflo(x[j].z) * w1[0]; acc[5] += bfhi(x[j].z) * w1[1]; acc[6] += bflo(x[j].w) * w1[2]; acc[7] += bfhi(x[j].w) * w1[3];
    }
#pragma unroll
    for (int i = 0; i < 8; ++i) acc[i] = acc[i] * sigmoidf_(acc[i]) * scale;
    u32x4 o; o.x = cvt_pk_bf16(acc[0], acc[1]); o.y = cvt_pk_bf16(acc[2], acc[3]); o.z = cvt_pk_bf16(acc[4], acc[5]); o.w = cvt_pk_bf16(acc[6], acc[7]);
    *(LAS u32x4*)(tile + s * ML_LDQ + d8 * 2) = o;
}
__device__ __forceinline__ void phase_mlstm_local(Frame& F, const Args& args, const bf16_t* proj, const float* gates, bf16_t* U, float* nU, float* scal) {
    LAS unsigned char* kt = F.lds + RING_OFF;
    LAS unsigned char* vt = F.lds + RING_OFF + 64 * ML_LDQ;
    const int lane = F.lane, w = F.wave, tid = F.tid;
    const float* convw = ain(F, IN_MCONV);
    const float* igb = ain(F, IN_MIGB); const float* fgb = ain(F, IN_MFGB);
    constexpr int NIT = NB * 8 * 64;
    unsigned zz = 0u; asm volatile("" : "+v"(zz)); const u32x4 zero4 = (u32x4){zz, zz, zz, zz};
    u32x4 kx[4], vx[2]; float gi = 0.f, gf = 0.f;
    auto prefetch = [&](int item) {
        const int c = item & 63, h = (item >> 6) & 7, b = item >> 9;
        const int s = tid >> 3, d8 = (tid & 7) * 8;
#pragma unroll
        for (int j = 0; j < 4; ++j) { const int sp = 64 * c + s - 3 + j; kx[j] = zero4; if (sp >= 0) kx[j] = *(const u32x4*)(proj + ((size_t)b * SEQ + sp) * MLP + 512 + h * 64 + d8); }
#pragma unroll
        for (int i = 0; i < 2; ++i) { const int pc = tid + i * 512, sv = pc >> 4, dv8 = (pc & 15) * 8;
            vx[i] = *(const u32x4*)(proj + ((size_t)b * SEQ + 64 * c + sv) * MLP + 1024 + h * 128 + dv8); }
        const size_t t = (size_t)b * SEQ + 64 * c + lane;
        gi = gates[t * 16 + h]; gf = gates[t * 16 + 8 + h];
    };
    if (F.vcu < NIT) prefetch(F.vcu);
    for (int item = F.vcu; item < NIT; item += F.G) {
        const int h = (item >> 6) & 7;
        float bc, a, g;
        { const float ig = gi + igb[h]; float v = logsigmoidf_(gf + fgb[h]);
#pragma unroll
          for (int o = 1; o < 64; o <<= 1) { const float u = __shfl_up(v, o); if (lane >= o) v += u; }
          bc = v; a = ig - v; float m = a;
#pragma unroll
          for (int o = 1; o < 64; o <<= 1) { const float u = __shfl_up(m, o); if (lane >= o) m = fmaxf(m, u); }
          g = m; }
        const float g63 = __shfl(g, 63), bL = __shfl(bc, 63);
        __syncthreads();
        { const int s = tid >> 3, d8 = (tid & 7) * 8; const float ws_ = fexp(__shfl(a, s) - g63);
          ml_conv_piece_pre(kx, convw, s, 512 + h * 64, d8, ws_, kt); }
#pragma unroll
        for (int i = 0; i < 2; ++i) { const int pc = tid + i * 512, s = pc >> 4, d8 = (pc & 15) * 8; *(LAS u32x4*)(vt + s * ML_LDV + d8 * 2) = vx[i]; }
        __syncthreads();
        if (item + F.G < NIT) prefetch(item + F.G);
        const int mt = w & 3, nh = w >> 2, gq = lane >> 4;
        f32x4 acc[4];
#pragma unroll
        for (int n = 0; n < 4; ++n) acc[n] = (f32x4){0.f, 0.f, 0.f, 0.f};
#pragma unroll
        for (int ks = 0; ks < 2; ++ks) {
            const bf16x8 af = frag_tr(kt, ML_LDQ, 32 * ks + 8 * gq, 32 * ks + 8 * gq + 4, 16 * mt, lane);
#pragma unroll
            for (int n = 0; n < 4; ++n) { const bf16x8 bfr = frag_tr(vt, ML_LDV, 32 * ks + 8 * gq, 32 * ks + 8 * gq + 4, 16 * (4 * nh + n), lane);
                acc[n] = MFMA16(af, bfr, acc[n]); }
        }
        bf16_t* Ui = U + (size_t)item * 8192;
#pragma unroll
        for (int n = 0; n < 4; ++n)
#pragma unroll
            for (int r = 0; r < 4; ++r) Ui[(16 * mt + 4 * gq + r) * 128 + 16 * (4 * nh + n) + (lane & 15)] = (bf16_t)(cvt_pk_bf16(acc[n][r], 0.f) & 0xffffu);
        if (tid < 64) { float s8[8];
#pragma unroll
            for (int q = 0; q < 8; ++q) s8[q] = 0.f;
#pragma unroll
            for (int r = 0; r < 64; ++r) s8[r & 7] += bf2f(*(const LAS unsigned short*)(kt + r * ML_LDQ + tid * 2));
            nU[(size_t)item * 64 + tid] = ((s8[0] + s8[1]) + (s8[2] + s8[3])) + ((s8[4] + s8[5]) + (s8[6] + s8[7])); }
        if (tid == 0) { scal[item * 2] = bL; scal[item * 2 + 1] = bL + g63; }
    }
    __syncthreads();
}

__device__ __forceinline__ void phase_mlstm_scan(Frame& F, const bf16_t* U, const float* nU, const float* scal, bf16_t* Cst, float* nst, float* mst) {
    constexpr int GP = 1024 + 8;
    for (int gi = blockIdx.x * NTHREADS + F.tid; gi < 64 * GP; gi += F.G * NTHREADS) {
        const int chain = gi / GP, e = gi % GP; const bool isn = e >= 1024;
        f32x4 v0 = (f32x4){0.f, 0.f, 0.f, 0.f}, v1 = v0; float m = 0.f;
        for (int c0 = 0; c0 < 64; c0 += 8) {
            f32x4 u0[8], u1[8]; float bl[8], ml[8];
#pragma unroll
            for (int j = 0; j < 8; ++j) { const int item = chain * 64 + c0 + j;
                if (isn) { const float* src = nU + (size_t)item * 64 + (e - 1024) * 8; u0[j] = *(const f32x4*)src; u1[j] = *(const f32x4*)(src + 4); }
                else { const u32x4 r = *(const u32x4*)(U + (size_t)item * 8192 + e * 8);
                    u0[j] = (f32x4){bflo(r.x), bfhi(r.x), bflo(r.y), bfhi(r.y)}; u1[j] = (f32x4){bflo(r.z), bfhi(r.z), bflo(r.w), bfhi(r.w)}; }
                bl[j] = scal[item * 2]; ml[j] = scal[item * 2 + 1]; }
#pragma unroll
            for (int j = 0; j < 8; ++j) { const int item = chain * 64 + c0 + j;
                if (isn) { float* d = nst + (size_t)item * 64 + (e - 1024) * 8; *(f32x4*)d = v0; *(f32x4*)(d + 4) = v1; if (e == 1024) mst[item] = m; }
                else { u32x4 o; o.x = cvt_pk_bf16(v0[0], v0[1]); o.y = cvt_pk_bf16(v0[2], v0[3]); o.z = cvt_pk_bf16(v1[0], v1[1]); o.w = cvt_pk_bf16(v1[2], v1[3]);
                    *(u32x4*)(Cst + (size_t)item * 8192 + e * 8) = o; }
                const float mn = fmaxf(bl[j] + m, ml[j]);
                const float dec = fexp(bl[j] + m - mn), sc = fexp(ml[j] - mn);
                v0 = v0 * dec + u0[j] * sc; v1 = v1 * dec + u1[j] * sc; m = mn; }
        }
    }
}

__device__ __forceinline__ void phase_mlstm_out(Frame& F, const Args& args, const bf16_t* proj, const float* gates, const bf16_t* Cst, const float* nst, const float* mst, bf16_t* Out) {
    constexpr int CH_BYTES = 2 * 64 * ML_LDQ + 2 * 64 * ML_LDV + 256;
    const int lane = F.lane, w = F.wave, tid = F.tid;
    const float* convw = ain(F, IN_MCONV); const float* normg = ain(F, IN_MNORMG);
    const int half = w >> 2, wq = w & 3, gq = lane >> 4, tq = lane & 15;
    LAS unsigned char* base = F.lds + RING_OFF + half * CH_BYTES;
    LAS unsigned char* qt = base; LAS unsigned char* kt = base + 64 * ML_LDQ; LAS unsigned char* vt = base + 2 * 64 * ML_LDQ; LAS unsigned char* ct = vt + 64 * ML_LDV;
    LAS float* nl = (LAS float*)(ct + 64 * ML_LDV);
    for (int it2 = F.vcu; it2 < NB * 8 * 32; it2 += F.G) {
        const int cp = it2 & 31, h = (it2 >> 5) & 7, b = it2 >> 8;
        __syncthreads();
#pragma unroll
        for (int ib = 0; ib < 2; ++ib) {
            u32x4 cx[2][4];
#pragma unroll
            for (int i2 = 0; i2 < 2; ++i2) { const int i = 2 * ib + i2; const int pc = tid + i * 512, hf = pc >> 10, tens = (pc >> 9) & 1, r = pc & 511, s = r >> 3, d8 = (r & 7) * 8; const int c = 2 * cp + hf;
#pragma unroll
                for (int j = 0; j < 4; ++j) { const int sp = 64 * c + s - 3 + j; cx[i2][j] = (u32x4){0u, 0u, 0u, 0u};
                    if (sp >= 0) cx[i2][j] = *(const u32x4*)(proj + ((size_t)b * SEQ + sp) * MLP + tens * 512 + h * 64 + d8); } }
#pragma unroll
            for (int i2 = 0; i2 < 2; ++i2) { const int i = 2 * ib + i2; const int pc = tid + i * 512, hf = pc >> 10, tens = (pc >> 9) & 1, r = pc & 511, s = r >> 3, d8 = (r & 7) * 8;
                LAS unsigned char* tl = F.lds + RING_OFF + hf * CH_BYTES + tens * 64 * ML_LDQ;
                ml_conv_piece_pre(cx[i2], convw, s, tens * 512 + h * 64, d8, tens ? 1.0f : 0.125f, tl); }
        }
        {
            u32x4 vv[4], cc[4];
#pragma unroll
            for (int i = 0; i < 4; ++i) { const int pc = tid + i * 512, hf = pc >> 10, r = pc & 1023, s = r >> 4, d8 = (r & 15) * 8; const int c = 2 * cp + hf;
                vv[i] = *(const u32x4*)(proj + ((size_t)b * SEQ + 64 * c + s) * MLP + 1024 + h * 128 + d8);
                const int item = (b * 8 + h) * 64 + c;
                cc[i] = *(const u32x4*)(Cst + (size_t)item * 8192 + s * 128 + d8); }
#pragma unroll
            for (int i = 0; i < 4; ++i) { const int pc = tid + i * 512, hf = pc >> 10, r = pc & 1023, s = r >> 4, d8 = (r & 15) * 8;
                LAS unsigned char* vb = F.lds + RING_OFF + hf * CH_BYTES + 2 * 64 * ML_LDQ;
                *(LAS u32x4*)(vb + s * ML_LDV + d8 * 2) = vv[i]; *(LAS u32x4*)(vb + 64 * ML_LDV + s * ML_LDV + d8 * 2) = cc[i]; }
        }
        if (tid < 128) { const int hf = tid >> 6, c = 2 * cp + hf, item = (b * 8 + h) * 64 + c;
            ((LAS float*)(F.lds + RING_OFF + hf * CH_BYTES + 2 * 64 * ML_LDQ + 2 * 64 * ML_LDV))[tid & 63] = nst[(size_t)item * 64 + (tid & 63)]; }
        const int c = 2 * cp + half, item = (b * 8 + h) * 64 + c;
        float bc, a, g; ml_gate_scan(gates, ain(F, IN_MIGB), ain(F, IN_MFGB), b, h, c, lane, bc, a, g);
        const float mc = mst[item];
        const float mt_l = fmaxf(mc, g);
        const int tt = 16 * wq + tq;
        const float mt_t = __shfl(mt_l, tt), b_t = __shfl(bc, tt);
        const float winter = fexp(mc - mt_t);
        __syncthreads();
        const bf16x8 qf0 = frag_row(qt, ML_LDQ, 16 * wq, 0, lane), qf1 = frag_row(qt, ML_LDQ, 16 * wq, 32, lane);
        f32x4 P[4]; float rs = 0.f;
#pragma unroll
        for (int kt_ = 0; kt_ < 4; ++kt_) {
            f32x4 s4 = (f32x4){0.f, 0.f, 0.f, 0.f};
            if (kt_ <= wq) {
                s4 = MFMA16(frag_row(kt, ML_LDQ, 16 * kt_, 0, lane), qf0, s4);
                s4 = MFMA16(frag_row(kt, ML_LDQ, 16 * kt_, 32, lane), qf1, s4);
            }
#pragma unroll
            for (int r = 0; r < 4; ++r) { const int s = 16 * kt_ + 4 * gq + r; const float as = __shfl(a, s);
                const float p = (s <= tt && kt_ <= wq) ? s4[r] * fexp(as - mt_t) : 0.f; P[kt_][r] = p; rs += p; }
        }
        rs += __shfl_xor(rs, 16); rs += __shfl_xor(rs, 32);
        float qn = 0.f;
#pragma unroll
        for (int i = 0; i < 16; ++i) { const int dk = 16 * gq + i; qn += bf2f(*(const LAS unsigned short*)(qt + tt * ML_LDQ + dk * 2)) * nl[dk]; }
        qn += __shfl_xor(qn, 16); qn += __shfl_xor(qn, 32);
        const float den = winter * qn + rs;
        const float dnm = fmaxf(fabsf(den), fexp(-(b_t + mt_t)));
        const float inv = fast_rcp(dnm);
        f32x4 acc[8];
#pragma unroll
        for (int n = 0; n < 8; ++n) { f32x4 z = (f32x4){0.f, 0.f, 0.f, 0.f};
            z = MFMA16(frag_tr(ct, ML_LDV, 8 * gq, 8 * gq + 4, 16 * n, lane), qf0, z);
            z = MFMA16(frag_tr(ct, ML_LDV, 32 + 8 * gq, 32 + 8 * gq + 4, 16 * n, lane), qf1, z);
            acc[n] = z * winter; }
#pragma unroll
        for (int pr = 0; pr < 2; ++pr) {
            if (2 * pr <= wq) {
                const bf16x8 pf = pack_bf16x8(P[2 * pr], P[2 * pr + 1]);
#pragma unroll
                for (int n = 0; n < 8; ++n) acc[n] = MFMA16(frag_tr(vt, ML_LDV, 32 * pr + 4 * gq, 32 * pr + 16 + 4 * gq, 16 * n, lane), pf, acc[n]);
            }
        }
        float sm = 0.f;
#pragma unroll
        for (int n = 0; n < 8; ++n) { acc[n] = acc[n] * inv; sm += (acc[n][0] + acc[n][1]) + (acc[n][2] + acc[n][3]); }
        sm += __shfl_xor(sm, 16); sm += __shfl_xor(sm, 32);
        const float mu = sm * (1.0f / 128.0f); float sq = 0.f;
#pragma unroll
        for (int n = 0; n < 8; ++n) { acc[n] = acc[n] - mu; sq += (acc[n][0] * acc[n][0] + acc[n][1] * acc[n][1]) + (acc[n][2] * acc[n][2] + acc[n][3] * acc[n][3]); }
        sq += __shfl_xor(sq, 16); sq += __shfl_xor(sq, 32);
        const float rstd = frsq(sq * (1.0f / 128.0f) + LN_EPS);
        const size_t trow = (size_t)b * SEQ + 64 * c + tt;
#pragma unroll
        for (int n = 0; n < 8; ++n) { const int dv = 16 * n + 4 * gq;
            const u32x2 ow = *(const u32x2*)(proj + trow * MLP + 2048 + h * 128 + dv); const f32x4 ng = *(const f32x4*)(normg + h * 128 + dv);
            const float o0 = acc[n][0] * rstd * ng[0] * sigmoidf_(bflo(ow.x)), o1 = acc[n][1] * rstd * ng[1] * sigmoidf_(bfhi(ow.x));
            const float o2 = acc[n][2] * rstd * ng[2] * sigmoidf_(bflo(ow.y)), o3 = acc[n][3] * rstd * ng[3] * sigmoidf_(bfhi(ow.y));
            u32x2 st; st.x = cvt_pk_bf16(o0, o1); st.y = cvt_pk_bf16(o2, o3);
            *(u32x2*)(Out + trow * D + h * 128 + dv) = st; }
    }
    __syncthreads();
}

constexpr int NSP = 2560, NS_LD = 144;
__device__ __forceinline__ void phase_nsa_compress(Frame& F, const bf16_t* proj, const bf16_t* WtK, const bf16_t* WtV, const float* cbias, const float* rc, const float* rs, bf16_t* KC, bf16_t* VC) {
    const int lane = F.lane, gq = lane >> 4, tq = lane & 15;
    const int gw = F.vcu * NWAVES + F.wave, NGW = F.G * NWAVES;
    for (int item = gw; item < NB * 4 * 16 * 2; item += NGW) {
        const int which = item & 1, ct = (item >> 1) & 15, g = (item >> 5) & 3, b = item >> 7;
        const bf16_t* Wt = which ? WtV : WtK;
        const int c_m = 16 * ct + tq;
        const bf16_t* arow = proj + ((size_t)b * SEQ + 16 * c_m) * NSP + (which ? 1280 : 1024) + g * 64 + 8 * gq;
        f32x4 acc[4];
#pragma unroll
        for (int n = 0; n < 4; ++n) acc[n] = (f32x4){0.f, 0.f, 0.f, 0.f};
#pragma unroll 4
        for (int ks = 0; ks < 64; ++ks) {
            const int l = ks >> 1, d0 = (ks & 1) * 32;
            bf16x8 af = (bf16x8){0, 0, 0, 0, 0, 0, 0, 0};
            if (16 * c_m + l < SEQ) af = *(const bf16x8*)(arow + (size_t)l * NSP + d0);
#pragma unroll
            for (int n = 0; n < 4; ++n) { const bf16x8 bfr = *(const bf16x8*)(Wt + (size_t)(16 * n + tq) * 2048 + 32 * ks + 8 * gq); acc[n] = MFMA16(af, bfr, acc[n]); }
        }
        const float b0 = cbias[which * 64 + tq], b1 = cbias[which * 64 + 16 + tq], b2 = cbias[which * 64 + 32 + tq], b3 = cbias[which * 64 + 48 + tq];
#pragma unroll
        for (int r = 0; r < 4; ++r) {
            const int c = 16 * ct + 4 * gq + r;
            const float x0 = acc[0][r] + b0, x1 = acc[1][r] + b1, x2 = acc[2][r] + b2, x3 = acc[3][r] + b3;
            bf16_t* dst = (which ? VC : KC) + (((size_t)b * 256 + c) * 4 + g) * 64;
            if (which) { dst[tq] = (bf16_t)f2bf(x0); dst[16 + tq] = (bf16_t)f2bf(x1); dst[32 + tq] = (bf16_t)f2bf(x2); dst[48 + tq] = (bf16_t)f2bf(x3); }
            else {
                const int pos = (16 * c + 31) & (SEQ - 1);
                const float c0 = rc[pos * 32 + tq], s0 = rs[pos * 32 + tq], c1 = rc[pos * 32 + 16 + tq], s1 = rs[pos * 32 + 16 + tq];
                const float y0 = x0 * c0 - x2 * s0, y2 = x0 * s0 + x2 * c0, y1 = x1 * c1 - x3 * s1, y3 = x1 * s1 + x3 * c1;
                dst[rope_phi(tq)] = (bf16_t)f2bf(y0); dst[rope_phi(16 + tq)] = (bf16_t)f2bf(y1); dst[rope_phi(32 + tq)] = (bf16_t)f2bf(y2); dst[rope_phi(48 + tq)] = (bf16_t)f2bf(y3);
            }
        }
    }
}

constexpr int NH = 2;
template <int MODE, int MK, class MaskF>
__device__ __forceinline__ void nsa_sub(const LAS unsigned char* kt, const LAS unsigned char* vt, int j0, int lane, const bf16x8 (&qf)[NH][2], const MaskF& valid, bool lanev,
                                        float (&m)[NH], float (&l)[NH], f32x4 (&acc)[NH][4], float (&psa)[4], float (&psb)[4]) {
    const int gq = lane >> 4;
    bf16x8 kf[2][2];
#pragma unroll
    for (int h2 = 0; h2 < 2; ++h2) { kf[h2][0] = frag_row(kt, NS_LD, j0 + 16 * h2, 0, lane); kf[h2][1] = frag_row(kt, NS_LD, j0 + 16 * h2, 32, lane); }
    bf16x8 vf[4];
    if (MODE != 0) frag_tr4<NS_LD>(vt, j0 + 4 * gq, lane, vf);
    bool ok[2][4];
    if (MK == 1) {
#pragma unroll
        for (int h2 = 0; h2 < 2; ++h2)
#pragma unroll
            for (int r = 0; r < 4; ++r) ok[h2][r] = valid(j0 + 16 * h2 + 4 * gq + r);
    }
#pragma unroll
    for (int jh = 0; jh < NH; ++jh) {
        f32x4 s[2];
#pragma unroll
        for (int h2 = 0; h2 < 2; ++h2) { f32x4 z = (f32x4){0.f, 0.f, 0.f, 0.f}; z = MFMA16(kf[h2][0], qf[jh][0], z); z = MFMA16(kf[h2][1], qf[jh][1], z); s[h2] = z; }
        if (MODE == 1) {
#pragma unroll
            for (int h2 = 0; h2 < 2; ++h2)
#pragma unroll
                for (int r = 0; r < 4; ++r) { const float p = ok[h2][r] ? fast_exp2(s[h2][r] * SM_C - m[jh]) * l[jh] : 0.f; s[h2][r] = p; }
#pragma unroll
            for (int r = 0; r < 4; ++r) { psa[r] += s[0][r]; psb[r] += s[1][r]; }
            const bf16x8 pf = pack_bf16x8(s[0], s[1]);
#pragma unroll
            for (int n = 0; n < 4; ++n) acc[jh][n] = MFMA16(vf[n], pf, acc[jh][n]);
        } else {
            if (MK == 1) {
#pragma unroll
                for (int h2 = 0; h2 < 2; ++h2)
#pragma unroll
                    for (int r = 0; r < 4; ++r) s[h2][r] = ok[h2][r] ? s[h2][r] : -3.0e38f;
            }
            float mx8 = fmaxf(fmaxf(fmaxf(s[0][0], s[0][1]), fmaxf(s[0][2], s[0][3])), fmaxf(fmaxf(s[1][0], s[1][1]), fmaxf(s[1][2], s[1][3])));
            const bool lv = (MK == 1) ? true : lanev;
            if (__any(lv && (mx8 * SM_C > m[jh] + 8.0f))) {
                float mx = lv ? mx8 * SM_C : NEG_BIG; mx = fmaxf(mx, NEG_BIG);
                mx = fmaxf(mx, __shfl_xor(mx, 16)); mx = fmaxf(mx, __shfl_xor(mx, 32));
                const float mnew = fmaxf(m[jh], mx), alpha = fast_exp2(m[jh] - mnew);
                l[jh] *= alpha; m[jh] = mnew;
                if (MODE == 2) {
#pragma unroll
                    for (int n = 0; n < 4; ++n) acc[jh][n] = acc[jh][n] * alpha;
                }
            }
            const float negm = lv ? -m[jh] : -3.0e38f;
            float ps = 0.f;
#pragma unroll
            for (int h2 = 0; h2 < 2; ++h2)
#pragma unroll
                for (int r = 0; r < 4; ++r) { const float pe = fast_exp2(__builtin_fmaf(s[h2][r], SM_C, negm)); s[h2][r] = pe; ps += pe; }
            l[jh] += ps;
            if (MODE == 2) {
                const bf16x8 pf = pack_bf16x8(s[0], s[1]);
#pragma unroll
                for (int n = 0; n < 4; ++n) acc[jh][n] = MFMA16(vf[n], pf, acc[jh][n]);
            }
        }
    }
}
__device__ __forceinline__ void nsa_blk64(const LAS unsigned char* KH, const LAS unsigned char* VH, int lane, const bf16x8 (&qf)[NH][2], int key0, int klo, int khi, bool lanev, bool full,
                                          float (&m)[NH], float (&l)[NH], f32x4 (&acc)[NH][4]) {
    const int gq = lane >> 4;
    f32x4 s[2][NH][2];
#pragma unroll
    for (int hf = 0; hf < 2; ++hf) {
        bf16x8 kf[2][2];
#pragma unroll
        for (int h2 = 0; h2 < 2; ++h2) { kf[h2][0] = frag_row(KH, NS_LD, 32 * hf + 16 * h2, 0, lane); kf[h2][1] = frag_row(KH, NS_LD, 32 * hf + 16 * h2, 32, lane); }
#pragma unroll
        for (int jh = 0; jh < NH; ++jh)
#pragma unroll
            for (int h2 = 0; h2 < 2; ++h2) { f32x4 z = (f32x4){0.f, 0.f, 0.f, 0.f}; z = MFMA16(kf[h2][0], qf[jh][0], z); z = MFMA16(kf[h2][1], qf[jh][1], z); s[hf][jh][h2] = z; }
    }
    if (!full) {
#pragma unroll
        for (int hf = 0; hf < 2; ++hf)
#pragma unroll
            for (int h2 = 0; h2 < 2; ++h2)
#pragma unroll
                for (int r = 0; r < 4; ++r) { const int key = key0 + 32 * hf + 16 * h2 + 4 * gq + r; const bool ok = (key >= klo) && (key <= khi);
#pragma unroll
                    for (int jh = 0; jh < NH; ++jh) s[hf][jh][h2][r] = ok ? s[hf][jh][h2][r] : -3.0e38f; }
    }
    const bool lv = lanev;
    float negm[NH];
#pragma unroll
    for (int jh = 0; jh < NH; ++jh) {
        float mx = NEG_BIG;
#pragma unroll
        for (int hf = 0; hf < 2; ++hf)
#pragma unroll
            for (int h2 = 0; h2 < 2; ++h2) mx = fmaxf(mx, fmaxf(fmaxf(s[hf][jh][h2][0], s[hf][jh][h2][1]), fmaxf(s[hf][jh][h2][2], s[hf][jh][h2][3])));
        mx = lv ? mx * SM_C : NEG_BIG; mx = fmaxf(mx, NEG_BIG);
        if (__any(mx > m[jh] + 8.0f)) {
            mx = fmaxf(mx, __shfl_xor(mx, 16)); mx = fmaxf(mx, __shfl_xor(mx, 32));
            const float mnew = fmaxf(m[jh], mx), alpha = fast_exp2(m[jh] - mnew);
            l[jh] *= alpha; m[jh] = mnew;
#pragma unroll
            for (int n = 0; n < 4; ++n) acc[jh][n] = acc[jh][n] * alpha;
        }
        negm[jh] = lv ? -m[jh] : -3.0e38f;
    }
#pragma unroll
    for (int hf = 0; hf < 2; ++hf) {
        bf16x8 vf[4]; frag_tr4<NS_LD>(VH, 32 * hf + 4 * gq, lane, vf);
#pragma unroll
        for (int jh = 0; jh < NH; ++jh) {
            float ps = 0.f;
#pragma unroll
            for (int h2 = 0; h2 < 2; ++h2)
#pragma unroll
                for (int r = 0; r < 4; ++r) { const float pe = fast_exp2(__builtin_fmaf(s[hf][jh][h2][r], SM_C, negm[jh])); s[hf][jh][h2][r] = pe; ps += pe; }
            l[jh] += ps;
            const bf16x8 pf = pack_bf16x8(s[hf][jh][0], s[hf][jh][1]);
#pragma unroll
            for (int n = 0; n < 4; ++n) acc[jh][n] = MFMA16(vf[n], pf, acc[jh][n]);
        }
    }
}
__device__ __forceinline__ void nsa_flush(u32x2 (&fin)[NH][4], unsigned char* Out8, size_t tok, int hbase, int lane, const float (&gpre)[NH][3], int branch, const f32x4 (&acc)[NH][4], const float (&sc)[NH], bool first) {
    const int gq = lane >> 4;
#pragma unroll
    for (int jh = 0; jh < NH; ++jh) {
        const float gt = sigmoidf_(branch == 0 ? gpre[jh][0] : (branch == 1 ? gpre[jh][1] : gpre[jh][2])) * sc[jh];
#pragma unroll
        for (int n = 0; n < 4; ++n) {
            float o0 = acc[jh][n][0] * gt, o1 = acc[jh][n][1] * gt, o2 = acc[jh][n][2] * gt, o3 = acc[jh][n][3] * gt;
            if (!first) { const u32x2 w = fin[jh][n]; o0 += bflo(w.x); o1 += bfhi(w.x); o2 += bflo(w.y); o3 += bfhi(w.y); }
            if (branch == 2) *(unsigned*)(Out8 + tok * D + (hbase + jh) * 64 + 16 * n + 4 * gq) = pk4_fp8(o0, o1, o2, o3);
            else { fin[jh][n].x = cvt_pk_bf16(o0, o1); fin[jh][n].y = cvt_pk_bf16(o2, o3); }
        }
    }
}

__device__ __forceinline__ void phase_nsa_attn(Frame& F, const bf16_t* proj, const float* gates, const bf16_t* KC, const bf16_t* VC, bf16_t* Out, unsigned char* Out8) {
    constexpr int OFF_KC = 0, OFF_VC = 256 * NS_LD, OFF_IMP = 2 * 256 * NS_LD, BUFB = 2 * 128 * NS_LD;
    const int lane = F.lane, w = F.wave, tid = F.tid, gq = lane >> 4, tq = lane & 15;
    LAS unsigned char* L = F.lds + RING_OFF;
    LAS float* impl = (LAS float*)(L + OFF_IMP) + w * 1024 + tq * 64;
    LAS float* impo = (LAS float*)(L + OFF_IMP) + (w ^ 4) * 1024 + tq * 64;
    const int nitems = NB * 4 * 64, nrounds = (nitems + F.G - 1) / F.G;
    for (int k = 0; k < nrounds; ++k) {
        const int item = F.vcu + k * F.G; if (item >= nitems) break;
        const int jr = item & 63, g = (item >> 6) & 3, b = item >> 8;
        const int jt = (k & 1) ? 63 - jr : jr;
        const int t0 = 64 * jt, tw = t0 + 16 * (w & 3), tme = tw + tq;
        const size_t tok = (size_t)b * SEQ + tme;
        const bf16_t* pb = proj + (size_t)b * SEQ * NSP;
        const int hbase = 4 * g + 2 * (w >> 2), qblk = jt;
        bf16x8 qf[NH][2];
#pragma unroll
        for (int jh = 0; jh < NH; ++jh) { qf[jh][0] = *(const bf16x8*)(proj + tok * NSP + (hbase + jh) * 64 + 8 * gq); qf[jh][1] = *(const bf16x8*)(proj + tok * NSP + (hbase + jh) * 64 + 32 + 8 * gq); }
        float gpre[NH][3];
#pragma unroll
        for (int jh = 0; jh < NH; ++jh)
#pragma unroll
            for (int br3 = 0; br3 < 3; ++br3) gpre[jh][br3] = gates[tok * 48 + (hbase + jh) * 3 + br3];
        float m[NH], l[NH], psa[4], psb[4]; f32x4 acc[NH][4];
        const int ncv = (t0 + 63 >= 31) ? ((t0 + 63 - 31) >> 4) + 1 : 0;
        const int ncb = (ncv + 31) >> 5;
        __syncthreads();
        for (int pc = tid; pc < ncb * 32 * 8 * 2; pc += NTHREADS) { const int tn = pc & 1, rr = pc >> 1, c = rr >> 3, d8 = (rr & 7) * 8;
            *(LAS u32x4*)(L + (tn ? OFF_VC : OFF_KC) + c * NS_LD + d8 * 2) = *(const u32x4*)((tn ? VC : KC) + (((size_t)b * 256 + c) * 4 + g) * 64 + d8); }
#pragma unroll
        for (int i = 0; i < 16; ++i) impl[4 * i + gq] = 0.f;
        __syncthreads();
        auto vcmp = [&](int c) { return 16 * c + 31 <= tme; };
#pragma unroll
        for (int jh = 0; jh < NH; ++jh) { m[jh] = NEG_BIG; l[jh] = 0.f; }
        const int ncw = (tw + 15 >= 31) ? ((((tw + 15 - 31) >> 4) + 1 + 31) >> 5) : 0;
#pragma clang loop unroll(disable)
        for (int kb = 0; kb < ncw; ++kb) nsa_sub<0, 1>(L + OFF_KC, L + OFF_VC, 32 * kb, lane, qf, vcmp, true, m, l, acc, psa, psb);
#pragma unroll
        for (int jh = 0; jh < NH; ++jh) { float lt = l[jh]; lt += __shfl_xor(lt, 16); lt += __shfl_xor(lt, 32); l[jh] = lt > 0.f ? fast_rcp(lt) : 0.f;
#pragma unroll
            for (int n = 0; n < 4; ++n) acc[jh][n] = (f32x4){0.f, 0.f, 0.f, 0.f}; }
        float prevb3 = 0.f;
#pragma clang loop unroll(disable)
        for (int kb = 0; kb < ncw; ++kb) {
#pragma unroll
            for (int r = 0; r < 4; ++r) { psa[r] = 0.f; psb[r] = 0.f; }
            nsa_sub<1, 1>(L + OFF_KC, L + OFF_VC, 32 * kb, lane, qf, vcmp, true, m, l, acc, psa, psb);
            const float upa_hi = __shfl(psa[3], (lane + 48) & 63), upa_lo = __shfl(prevb3, (lane + 48) & 63);
            const float upb_hi = __shfl(psb[3], (lane + 48) & 63);
            const float ea = (gq >= 1) ? upa_hi : upa_lo;
            const float eb = (gq >= 1) ? upb_hi : upa_hi;
            impl[8 * kb + gq] = (psa[0] + psa[1]) + (psa[2] + psa[3]) + ea;
            impl[8 * kb + 4 + gq] = (psb[0] + psb[1]) + (psb[2] + psb[3]) + eb;
            prevb3 = psb[3];
        }
        u32x2 fin[NH][4];
        { const float one[NH] = {1.f, 1.f}; nsa_flush(fin, Out8, tok, hbase, lane, gpre, 0, acc, one, true); }
        __syncthreads();
        const int sj = (tid & 511) >> 3, sd8 = (tid & 7) * 8;
        const bf16_t* srow = pb + (size_t)sj * NSP + g * 64 + sd8;
        u32x4 pre[4];
        auto ldstage = [&](int kc, int st_) {
#pragma unroll
            for (int i = 0; i < 4; ++i) pre[i] = *(const u32x4*)(srow + (size_t)(128 * st_ + 64 * (i & 1)) * NSP + kc + ((i >> 1) ? 256 : 0)); };
        ldstage(1536, 0);
        const int nlo_w = (t0 - 511 > 0) ? ((t0 - 511) >> 6) : 0;
        unsigned long long selmask;
        if (qblk < 16) selmask = (2ull << qblk) - 1ull;
        else {
            unsigned pk[16];
#pragma unroll
            for (int i = 0; i < 16; ++i) { const int n = 4 * i + gq; const bool forced = (n == 0) || (n == qblk) || (n == qblk - 1);
                const float v = forced ? 1.0e4f : (impl[n] + impo[n]) + 1.0f;
                pk[i] = (n > qblk) ? 0u : ((__float_as_uint(v) & ~63u) | (unsigned)(63 - n)); }
            selmask = 0ull;
#pragma clang loop unroll(disable)
            for (int it = 0; it < 16; ++it) {
                unsigned cur = pk[0];
#pragma unroll
                for (int i = 1; i < 16; ++i) cur = cur > pk[i] ? cur : pk[i];
                { const unsigned o = (unsigned)__shfl_xor((int)cur, 16); cur = cur > o ? cur : o; }
                { const unsigned o = (unsigned)__shfl_xor((int)cur, 32); cur = cur > o ? cur : o; }
                if (cur != 0u) selmask |= 1ull << (63 - (cur & 63u));
#pragma unroll
                for (int i = 0; i < 16; ++i) pk[i] = (pk[i] == cur) ? 0u : pk[i];
            }
        }
#pragma unroll 1
        for (int br = 1; br <= 2; ++br) {
            const int nlo = (br == 1) ? 0 : nlo_w;
            const int kcol = (br == 1) ? 1536 : 2048, vcol = kcol + 256;
#pragma unroll
            for (int jh = 0; jh < NH; ++jh) { m[jh] = NEG_BIG; l[jh] = 0.f;
#pragma unroll
                for (int n = 0; n < 4; ++n) acc[jh][n] = (f32x4){0.f, 0.f, 0.f, 0.f}; }
            const int s_lo = nlo >> 1, s_hi = qblk >> 1;
            int bf = 0;
            __syncthreads();
#pragma clang loop unroll(disable)
            for (int st = s_lo; st <= s_hi; ++st) {
                LAS unsigned char* KB = L + bf * BUFB; LAS unsigned char* VB = KB + 128 * NS_LD;
#pragma unroll
                for (int i = 0; i < 4; ++i) *(LAS u32x4*)(((i >> 1) ? VB : KB) + (sj + 64 * (i & 1)) * NS_LD + sd8 * 2) = pre[i];
                __syncthreads();
                if (st < s_hi) {
#pragma unroll
                    for (int i = 0; i < 4; ++i) pre[i] = *(const u32x4*)(srow + (size_t)(128 * (st + 1) + 64 * (i & 1)) * NSP + ((i >> 1) ? vcol : kcol)); }
#pragma clang loop unroll(disable)
                for (int hb = 0; hb < 2; ++hb) {
                    const int nb = 2 * st + hb;
                    if (nb < nlo || nb > qblk) continue;
                    const LAS unsigned char* KH = KB + hb * 64 * NS_LD; const LAS unsigned char* VH = VB + hb * 64 * NS_LD;
                    bool lanev = true, full; int klo = 0;
                    if (br == 1) { lanev = (selmask >> nb) & 1ull; if (__ballot(lanev) == 0ull) continue; full = nb < qblk; }
                    else { if (64 * nb + 63 < tw - 511) continue; klo = tme - 511; full = (64 * nb >= tw + 15 - 511) && (64 * nb + 63 <= tw); }
                    nsa_blk64(KH, VH, lane, qf, 64 * nb, klo, tme, lanev, full, m, l, acc);
                }
                bf ^= 1;
            }
            if (br == 1) ldstage(2048, nlo_w >> 1);
            float sc[NH];
#pragma unroll
            for (int jh = 0; jh < NH; ++jh) { float lt = l[jh]; lt += __shfl_xor(lt, 16); lt += __shfl_xor(lt, 32); sc[jh] = lt > 0.f ? fast_rcp(lt) : 0.f; }
            nsa_flush(fin, Out8, tok, hbase, lane, gpre, br, acc, sc, false);
        }
    }
    __syncthreads();
}


__device__ __forceinline__ void phase_pool_diff(Frame& F, const bf16_t* X, bf16_t* Dst) {
    const int gw = F.vcu * NWAVES + F.wave, NGW = F.G * NWAVES, lane = F.lane;
    constexpr int RUN = 16, NRUN = SEQ / RUN;
    for (int item = gw; item < NB * NRUN * 4; item += NGW) {
        const int grp = item & 3, run = (item >> 2) % NRUN, b = item / (4 * NRUN);
        const int w = 2 << grp, s0 = run * RUN, col = grp * 256 + 4 * lane;
        const bf16_t* xb = X + ((size_t)b * SEQ) * D + col;
        u32x2 raw[RUN + 15];
#pragma unroll
        for (int r = 0; r < RUN + 15; ++r) { const int s = s0 - 15 + r; raw[r] = (u32x2){0u, 0u}; if (s >= 0 && r >= 16 - w) raw[r] = *(const u32x2*)(xb + (size_t)s * D); }
        f32x4 sum = (f32x4){0.f, 0.f, 0.f, 0.f};
#pragma unroll
        for (int r = 0; r < 15; ++r) if (r >= 16 - w) sum += (f32x4){bflo(raw[r].x), bfhi(raw[r].x), bflo(raw[r].y), bfhi(raw[r].y)};
#pragma unroll
        for (int i = 0; i < RUN; ++i) {
            const int s = s0 + i;
            const f32x4 xv = (f32x4){bflo(raw[15 + i].x), bfhi(raw[15 + i].x), bflo(raw[15 + i].y), bfhi(raw[15 + i].y)};
            sum += xv;
            const float inv = fast_rcp((float)((s + 1 < w) ? (s + 1) : w));
            const f32x4 dv = sum * inv - xv;
            u32x2 o; o.x = cvt_pk_bf16(dv[0], dv[1]); o.y = cvt_pk_bf16(dv[2], dv[3]);
            *(u32x2*)(Dst + ((size_t)b * SEQ + s) * D + col) = o;
#pragma unroll
            for (int k = 1; k <= 4; ++k) if (w == (1 << k)) { const u32x2 rr = raw[15 + i - (1 << k) + 1]; sum -= (f32x4){bflo(rr.x), bfhi(rr.x), bflo(rr.y), bfhi(rr.y)}; }
        }
    }
}

#define HAVE_MIXER(l) true
__host__ __device__ inline bool phase_used_lk(int l, int k) {
    if (k == 14) return false;
    if (k == 0 || k >= 7) return true;
    if (l == 3) return k == 2 || k == 6;
    if (l == 0) return k == 1 || k == 2 || k == 3 || k == 4 || k == 6;
    if (l == 2) return k == 1 || k == 2 || k == 3 || k == 6;
    if (l == 1) return k == 1 || k == 2 || k == 3 || k == 6;
    return false;
}
__host__ __device__ inline bool phase_used(int ph) { return phase_used_lk(ph / 16, ph % 16); }
#ifndef MIX_ONLY
#define MIX_ONLY -1
#endif
#define MIXL(x) (MIX_ONLY < 0 || MIX_ONLY == (x))
#ifndef ONE_LAUNCH
#define ONE_LAUNCH 1
#endif
#define ML_U   (ws + WS_R1 + 192 * MiB)
#define ML_CST (ws + WS_R1 + 320 * MiB)
#define ML_NU  (ws + WS_MSC)
#define ML_NST (ws + WS_MSC + 1 * MiB)
#define ML_SCAL (ws + WS_MSC + 2 * MiB)
#define ML_MST (ws + WS_MSC + 2 * MiB + 512 * 1024)
__device__ __forceinline__ unsigned char* flatp(GAS unsigned char* p) { unsigned char* q = (unsigned char*)p; asm volatile("" : "+s"(q)); return q; }
#define MIXER_PHASES \
        if (MIXL(0) && l == 0) { \
            if (IN(PH_MIX_IN)) for (int rep_ = 0; rep_ < NREP(PH_MIX_IN); ++rep_) { \
                pg8::Gemm g{xb_in, (const bf16_t*)(wb + W_MIXIN), D, D, D}; pg8::SchedPlain S; S.init(T, 3328, F.G, (int)blockIdx.x, D, D, 0); \
                EpiProj E{(bf16_t*)(ws + WS_R1), 3072, 0, (float*)(ws + WS_AUX), 16, 12, nullptr, nullptr, nullptr}; \
                pg8::gemm_phase<EpiProj, pg8::SchedPlain, false, false>(F.lds + RING_OFF, g, S, E); \
                SEAM(PH_MIX_IN); } \
            if (IN(PH_MIX_A)) for (int rep_ = 0; rep_ < NREP(PH_MIX_A); ++rep_) { phase_mlstm_local(F, args, (const bf16_t*)(ws + WS_R1), (const float*)(ws + WS_AUX), (bf16_t*)ML_U, (float*)ML_NU, (float*)ML_SCAL); SEAM(PH_MIX_A); } \
            if (IN(PH_MIX_B)) for (int rep_ = 0; rep_ < NREP(PH_MIX_B); ++rep_) { phase_mlstm_scan(F, (const bf16_t*)ML_U, (const float*)ML_NU, (const float*)ML_SCAL, (bf16_t*)ML_CST, (float*)ML_NST, (float*)ML_MST); SEAM(PH_MIX_B); } \
            if (IN(PH_MIX_C)) for (int rep_ = 0; rep_ < NREP(PH_MIX_C); ++rep_) { phase_mlstm_out(F, args, (const bf16_t*)(ws + WS_R1), (const float*)(ws + WS_AUX), (const bf16_t*)ML_CST, (const float*)ML_NST, (const float*)ML_MST, (bf16_t*)(ws + WS_R2)); SEAM(PH_MIX_C); } \
            if (IN(PH_MIX_OUT)) for (int rep_ = 0; rep_ < NREP(PH_MIX_OUT); ++rep_) { \
                pg8::Gemm g{(const bf16_t*)(ws + WS_R2), (const bf16_t*)(wb + W_MIXOUT), D, D, D}; pg8::SchedPlain S; S.init(T, D, F.G, (int)blockIdx.x, D, D, 0); \
                EpiBf16 E{nullptr, D, nullptr, (unsigned char*)(ws + WS_R1)}; \
                pg8::gemm_phase<EpiBf16, pg8::SchedPlain, false, false>(F.lds + RING_OFF, g, S, E); \
                SEAM(PH_MIX_OUT); } \
        } \
        if (MIXL(1) && l == 1) { \
            if (IN(PH_MIX_IN)) for (int rep_ = 0; rep_ < NREP(PH_MIX_IN); ++rep_) { \
                pg8::Gemm g{(const bf16_t*)x8_in, (const bf16_t*)(wb + W_MIXIN), D / 2, D / 2, D / 2}; pg8::SchedPlain S; S.init(T, 2816, F.G, (int)blockIdx.x, D / 2, D / 2, 0); \
                EpiProj E{(bf16_t*)(ws + WS_R1), 2560, 1, (float*)(ws + WS_AUX), 48, 10, (const float*)(ws + WS_ROPE), (const float*)(ws + WS_ROPE) + SEQ * 32, nullptr}; \
                pg8::gemm_phase<EpiProj, pg8::SchedPlain, false, true>(F.lds + RING_OFF, g, S, E); \
                SEAM(PH_MIX_IN); } \
            if (IN(PH_MIX_A)) for (int rep_ = 0; rep_ < NREP(PH_MIX_A); ++rep_) { phase_nsa_compress(F, (const bf16_t*)(ws + WS_R1), (const bf16_t*)(wb + W_CMPK), (const bf16_t*)(wb + W_CMPV), (const float*)(wb + W_CMPB), \
                (const float*)(ws + WS_ROPE), (const float*)(ws + WS_ROPE) + SEQ * 32, (bf16_t*)(ws + WS_R1 + 160 * MiB), (bf16_t*)(ws + WS_R1 + 161 * MiB)); SEAM(PH_MIX_A); } \
            if (IN(PH_MIX_B)) for (int rep_ = 0; rep_ < NREP(PH_MIX_B); ++rep_) { phase_nsa_attn(F, (const bf16_t*)flatp(ws + WS_R1), (const float*)flatp(ws + WS_AUX), (const bf16_t*)flatp(ws + WS_R1 + 160 * MiB), (const bf16_t*)flatp(ws + WS_R1 + 161 * MiB), (bf16_t*)flatp(ws + WS_R2), (unsigned char*)flatp(ws + WS_R2 + 64 * MiB)); SEAM(PH_MIX_B); } \
            if (IN(PH_MIX_OUT)) for (int rep_ = 0; rep_ < NREP(PH_MIX_OUT); ++rep_) { \
                pg8::Gemm g{(const bf16_t*)(ws + WS_R2 + 64 * MiB), (const bf16_t*)(wb + W_MIXOUT), D / 2, D / 2, D / 2}; pg8::SchedPlain S; S.init(T, D, F.G, (int)blockIdx.x, D / 2, D / 2, 0); \
                EpiBf16 E{nullptr, D, nullptr, (unsigned char*)(ws + WS_R1)}; \
                pg8::gemm_phase<EpiBf16, pg8::SchedPlain, false, true>(F.lds + RING_OFF, g, S, E); \
                SEAM(PH_MIX_OUT); } \
        } \
        if (MIXL(2) && l == 2) { \
            if (IN(PH_MIX_IN)) for (int rep_ = 0; rep_ < NREP(PH_MIX_IN); ++rep_) { \
                pg8::Gemm g{(const bf16_t*)x8_in, (const bf16_t*)(wb + W_MIXIN), D / 2, D / 2, D / 2}; pg8::SchedPlain S; S.init(T, 7168, F.G, (int)blockIdx.x, D / 2, D / 2, 0); \
                EpiProj E{(bf16_t*)(ws + WS_R1), 7168, 2, nullptr, 0, -1, (const float*)(ws + WS_ROPE), (const float*)(ws + WS_ROPE) + SEQ * 32, (unsigned char*)(ws + WS_R1)}; \
                pg8::gemm_phase<EpiProj, pg8::SchedPlain, false, true>(F.lds + RING_OFF, g, S, E); \
                SEAM(PH_MIX_IN); } \
            if (IN(PH_MIX_A)) for (int rep_ = 0; rep_ < NREP(PH_MIX_A); ++rep_) { phase_dilated_attn(F, (const unsigned char*)(ws + WS_R1), (unsigned char*)(ws + WS_R1 + 448 * MiB), (unsigned char*)(ws + WS_R1 + 512 * MiB), (unsigned char*)(ws + WS_R2), (float*)(ws + WS_AUX)); SEAM(PH_MIX_A); } \
            if (IN(PH_MIX_B)) for (int rep_ = 0; rep_ < NREP(PH_MIX_B); ++rep_) { phase_dilated_combine(F, (const unsigned char*)(ws + WS_R1 + 448 * MiB), (const unsigned char*)(ws + WS_R1 + 512 * MiB), (const unsigned char*)(ws + WS_R2), (const float*)(ws + WS_AUX), (unsigned char*)(ws + WS_R2 + 64 * MiB)); SEAM(PH_MIX_B); } \
            if (IN(PH_MIX_OUT)) for (int rep_ = 0; rep_ < NREP(PH_MIX_OUT); ++rep_) { \
                pg8::Gemm g{(const bf16_t*)(ws + WS_R2 + 64 * MiB), (const bf16_t*)(wb + W_MIXOUT), D / 2, D / 2, D / 2}; pg8::SchedPlain S; S.init(T, D, F.G, (int)blockIdx.x, D / 2, D / 2, 0); \
                EpiBf16 E{nullptr, D, nullptr, (unsigned char*)(ws + WS_R1)}; \
                pg8::gemm_phase<EpiBf16, pg8::SchedPlain, false, true>(F.lds + RING_OFF, g, S, E); \
                SEAM(PH_MIX_OUT); } \
        } \
        if (MIXL(3) && l == 3) { \
            if (IN(PH_MIX_A)) for (int rep_ = 0; rep_ < NREP(PH_MIX_A); ++rep_) { phase_pool_diff(F, xb_in, (bf16_t*)(ws + WS_R2)); SEAM(PH_MIX_A); } \
            if (IN(PH_MIX_OUT)) for (int rep_ = 0; rep_ < NREP(PH_MIX_OUT); ++rep_) { \
                pg8::Gemm g{(const bf16_t*)(ws + WS_R2), (const bf16_t*)(wb + W_MIXOUT), D, 256, 256}; pg8::SchedPlain S; S.init(T, D, F.G, (int)blockIdx.x, D, 256, 256); \
                EpiBf16 E{nullptr, D, ain(F, IN_POOLS), (unsigned char*)(ws + WS_R1)}; \
                pg8::gemm_phase<EpiBf16, pg8::SchedPlain, false, false>(F.lds + RING_OFF, g, S, E); \
                SEAM(PH_MIX_OUT); } \
        }

#ifndef PROBE_K
#define NREP(k) 1
#else
#define NREP(k) (((PROBE_L) < 0 || (PROBE_L) == l) && (((PROBE_K) >> (k)) & 1) ? (PROBE_R) : 1)
#endif
#ifndef PROBE_DUP
#define PROBE_DUP 0
#endif
#define DUPN(k) (((PROBE_DUP) >> (k)) & 1 ? 2 : 1)
#ifndef PROBE_SKIP_EPI
#define PROBE_SKIP_EPI 0
#endif
#ifndef PH_ONLY
#define PH_ONLY -1
#endif
constexpr int PH_PER_LAYER = 16, NPHASES = DEPTH * PH_PER_LAYER;
enum { PH_CONV = 0, PH_MIX_IN = 1, PH_MIX_A = 2, PH_MIX_B = 3, PH_MIX_C = 4, PH_MIX_D = 5, PH_MIX_OUT = 6, PH_LN1 = 7, PH_ROUTER = 8, PH_ROUTE1 = 9, PH_ROUTE2 = 10,
       PH_GATEUP = 11, PH_DOWN = 12, PH_LN2 = 13, PH_PW = 14, PH_PLE = 15 };

#define wb (ws + WS_W)
__device__ __forceinline__ void launder_ptr(GAS unsigned char*& p) { asm volatile("" : "+s"(p)); }
__global__ void __launch_bounds__(NTHREADS, 2) fwd_kernel(Args args) {
    extern __shared__ __attribute__((aligned(16))) unsigned char lds[];
    Frame F;
    F.lds = (LAS unsigned char*)lds;
    F.tid = threadIdx.x; F.lane = F.tid & 63; F.wave = __builtin_amdgcn_readfirstlane(F.tid >> 6);
    F.G = gridDim.x; { const int bx = blockIdx.x; F.vcu = (F.G % 8 == 0) ? (bx % 8) * (F.G / 8) + bx / 8 : bx; }
    F.ws = (GAS unsigned char*)args.ws; F.ctl = (unsigned*)(args.ws + WS_CTL); F.out = (GAS float*)args.out;
    volatile LAS unsigned* MISC = (volatile LAS unsigned*)(F.lds + MISC_OFF);
    for (int u = F.tid; u < (LDS_BYTES - MISC_OFF) / 4; u += NTHREADS) ((LAS unsigned*)(F.lds + MISC_OFF))[u] = 0u;
    __syncthreads();
    if (F.tid == 0) {
        LAS unsigned long long* pt = (LAS unsigned long long*)(F.lds + PTAB_OFF);
#pragma unroll
        for (int i = 0; i < N_IN; ++i) pt[i] = (unsigned long long)args.in[i];
    }
    __syncthreads();
    const int lo = args.ph_lo, hi = args.ph_hi;
    XcdBarrier bar; bar.bar = F.ctl + CW_BAR; bar.x = 0; bar.st = nullptr;
    if (hi - lo > 1) bar = xcd_barrier_post(F.ctl + CW_BAR, MISC + 8);

    for (int l = 0; l < DEPTH; ++l) {
        const int pb = l * PH_PER_LAYER;
        GAS unsigned char* ws = (GAS unsigned char*)args.ws; asm volatile("" : "+s"(ws));
#define IN(k) ((PH_ONLY < 0 || PH_ONLY == (k)) && lo <= pb + (k) && pb + (k) < hi && (F.refresh(), launder_ptr(ws), true))
#define SEAM(k) do { if (pb + (k) + 1 < hi) xcd_barrier(bar); } while (0)
        bf16_t* const xb_in = (bf16_t*)(ws + ((l & 1) ? WS_XB1 : WS_XB0));
        bf16_t* const xb_mid = (bf16_t*)(ws + ((l & 1) ? WS_XB0 : WS_XB1));
        unsigned char* const x8_in = (unsigned char*)(ws + ((l & 1) ? WS_X8B : WS_X8A));
        unsigned char* const x8_out = (unsigned char*)(ws + ((l & 1) ? WS_X8A : WS_X8B));

        if (IN(PH_CONV)) for (int rep_ = 0; rep_ < NREP(PH_CONV); ++rep_) {
            if (l == 0) { phase_convert(F, args, l, CONV_MASK_ALL, F.vcu, F.G, true); SEAM(PH_CONV); }
            else { phase_convert(F, args, l, CONV_MASK_LATE, F.vcu, F.G, false); __syncthreads(); }
        }

        MIXER_PHASES

        if (IN(PH_LN1)) {
            if (HAVE_MIXER(l)) phase_ln<1>(F, xb_in, (const bf16_t*)(ws + WS_R1), ain(F, IN_LNG) + (size_t)l * 2 * D, ain(F, IN_LNB) + (size_t)l * 2 * D, xb_mid, nullptr, nullptr, 0, x8_out);
            else phase_ln<0>(F, xb_in, nullptr, ain(F, IN_LNG) + (size_t)l * 2 * D, ain(F, IN_LNB) + (size_t)l * 2 * D, xb_mid, nullptr, nullptr, 0);
            SEAM(PH_LN1);
        }
        if (IN(PH_ROUTER)) for (int rep_ = 0; rep_ < NREP(PH_ROUTER); ++rep_) {
            pg8::Gemm g{xb_mid, (const bf16_t*)(wb + W_ROUTER), D, D, D}; pg8::SchedPlain S; S.init(T, 256, F.G, (int)blockIdx.x, D, D, 0);
            EpiRouter E{(float*)(ws + WS_LOGITS)};
            pg8::gemm_phase<EpiRouter, pg8::SchedPlain, false>(F.lds + RING_OFF, g, S, E);
            if (F.G == 256) {
                F.refresh();
                pg8::Gemm g2{(const bf16_t*)(ws + WS_PBF), (const bf16_t*)(wb + W_PLEW), 256, 256, 256}; pg8::SchedPw S2; S2.c = (int)blockIdx.x; S2.lda = 256; S2.ldb = 256;
                EpiProj E2{nullptr, D, 0, nullptr, 0, -1, nullptr, nullptr, (unsigned char*)(ws + WS_R1 + 320 * MiB)};
                pg8::gemm_phase<EpiProj, pg8::SchedPw, false>(F.lds + RING_OFF, g2, S2, E2);
            } else {
                F.refresh();
                pg8::Gemm g2{(const bf16_t*)(ws + WS_PBF), (const bf16_t*)(wb + W_PLEW), 256, 256, 256}; pg8::SchedPlain S2; S2.init(T, D, F.G, (int)blockIdx.x, 256, 256, 0);
                EpiProj E2{nullptr, D, 0, nullptr, 0, -1, nullptr, nullptr, (unsigned char*)(ws + WS_R1 + 320 * MiB)};
                pg8::gemm_phase<EpiProj, pg8::SchedPlain, false>(F.lds + RING_OFF, g2, S2, E2);
            }
            SEAM(PH_ROUTER);
        }
        if (IN(PH_ROUTE1)) for (int rep_ = 0; rep_ < NREP(PH_ROUTE1); ++rep_) {
            phase_route1(F, (const float*)(ws + WS_LOGITS), ain(F, IN_RBIAS) + l * NEXP, (int*)(ws + WS_EIDX), (float*)(ws + WS_GW), (int*)(ws + WS_LRANK), (int*)(ws + WS_BLKHIST));
            SEAM(PH_ROUTE1);
        }
        if (IN(PH_ROUTE2)) for (int rep_ = 0; rep_ < NREP(PH_ROUTE2); ++rep_) {
            phase_route2(F, (const int*)(ws + WS_EIDX), (const int*)(ws + WS_LRANK), (const int*)(ws + WS_BLKHIST), (int*)(ws + WS_POSK), (int*)(ws + WS_ROWTOK), (int*)(ws + WS_TILEE), (int*)(ws + WS_MOEMETA));
            SEAM(PH_ROUTE2);
        }
        if (IN(PH_GATEUP) || IN(PH_DOWN)) {
            const int* meta = (const int*)(ws + WS_MOEMETA);
            const int ntiles = __builtin_amdgcn_readfirstlane(meta[1]);
            LAS int* tab = (LAS int*)(F.lds + TAB_OFF);
            for (int i = F.tid; i < ntiles && i < 2048; i += NTHREADS) tab[i] = ((const int*)(ws + WS_TILEE))[i];
            __syncthreads();
            if (IN(PH_GATEUP)) for (int rep_ = 0; rep_ < NREP(PH_GATEUP); ++rep_) {
                pg8::Gemm g{(const bf16_t*)x8_out, (const bf16_t*)(wb + W_EGU), D / 2, D / 2, D / 2};
                pg8::SchedMoe S; S.tile_e = tab; S.row_token = (const int*)(ws + WS_ROWTOK); S.n_units = ntiles * 2; S.npn = 2; S.G = F.G; S.c = F.vcu; S.lda = D / 2; S.ldb = D / 2; S.rev = 0;
#ifdef PROBE_HOTAB
                S.hot = 0;
#endif
                EpiSwiGLU E{(unsigned char*)(ws + WS_R2)};
                pg8::gemm_phase<EpiSwiGLU, pg8::SchedMoe, true, true>(F.lds + RING_OFF, g, S, E, F.lds + VAN_OFF);
                if (l + 1 < DEPTH) {
                    int r_ = (ntiles * 2) % F.G, ni_ = r_ ? F.G - r_ : F.G; if (ni_ < 64) { r_ = 0; ni_ = F.G; }
                    const int wi_ = F.vcu - r_;
                    if (wi_ >= 0) { F.refresh(); phase_convert(F, args, l + 1, CONV_MASK_EARLY, wi_, ni_, true); }
                }
                SEAM(PH_GATEUP);
            }
            if (IN(PH_DOWN)) for (int rep_ = 0; rep_ < NREP(PH_DOWN); ++rep_) {
                pg8::Gemm g{(const bf16_t*)(ws + WS_R2), (const bf16_t*)(wb + W_EDN), EFF / 2, EFF / 2, EFF / 2};
                pg8::SchedMoe S; S.tile_e = tab; S.row_token = nullptr; S.n_units = ntiles * 4; S.npn = 4; S.G = F.G; S.c = F.vcu; S.lda = EFF / 2; S.ldb = EFF / 2; S.rev = 1;
#ifdef PROBE_HOTAB
                S.hot = rep_ > 0 ? PROBE_HOTAB : 0;
#endif
#ifdef PROBE_Y8
                EpiY8 E{(unsigned char*)(ws + WS_R1 + (rep_ > 0 ? 384 * MiB : 0)), D, rep_ > 0 ? PROBE_Y8 : 0};
#else
                EpiY8 E{(unsigned char*)(ws + WS_R1), D};
#endif
#ifdef STAGGER_DOWN
                { const int stg_ = (F.vcu >> 3) & 3; for (int i_ = 0; i_ < stg_; ++i_) __builtin_amdgcn_s_sleep(STAGGER_DOWN); }
#endif
                pg8::gemm_phase<EpiY8, pg8::SchedMoe, false, true>(F.lds + RING_OFF, g, S, E);
                SEAM(PH_DOWN);
            }
        }
        if (IN(PH_LN2)) {
            const int shbase = __builtin_amdgcn_readfirstlane(((const int*)(ws + WS_MOEMETA))[0]);
            phase_ln<2>(F, xb_mid, (const void*)(ws + WS_R1), ain(F, IN_LNG) + (size_t)l * 2 * D + D, ain(F, IN_LNB) + (size_t)l * 2 * D + D, xb_in, (const int*)(ws + WS_POSK), (const float*)(ws + WS_GW), shbase, x8_in);
            SEAM(PH_LN2);
        }
        if (IN(PH_PLE)) {
            pg8::Gemm g{(const bf16_t*)x8_in, (const bf16_t*)(wb + W_PLEG), D / 2, D / 2, D / 2}; pg8::SchedPlain S; S.init(T, D, F.G, (int)blockIdx.x, D / 2, D / 2, 0);
            EpiPLE E{xb_in, (const unsigned char*)(ws + WS_R1 + 320 * MiB), xb_mid, (l == DEPTH - 1) ? (float*)F.out : (float*)nullptr, x8_out};
            pg8::gemm_phase<EpiPLE, pg8::SchedPlain, false, true>(F.lds + RING_OFF, g, S, E);
            SEAM(PH_PLE);
        }
#undef IN
#undef SEAM
    }
}

extern "C" void kernel_launch(void* const* d_in, const int* in_sizes, int n_in, void* d_out, int out_size, void* d_ws, size_t ws_size, hipStream_t stream) {
    static int grid = 0;
    if (grid == 0) {
        if (n_in != N_IN || out_size != T * D || ws_size < WS_END) { fprintf(stderr, "kernel_launch: bad shapes: n_in %d out %d ws %zu (need %zu)\n", n_in, out_size, ws_size, (size_t)WS_END); grid = -1; return; }
        int dev = 0, cus = 0, per_cu = 0;
        if (hipGetDevice(&dev) != hipSuccess || hipDeviceGetAttribute(&cus, hipDeviceAttributeMultiprocessorCount, dev) != hipSuccess) { grid = -1; return; }
        if (hipFuncSetAttribute((const void*)fwd_kernel, hipFuncAttributeMaxDynamicSharedMemorySize, LDS_BYTES) != hipSuccess) { fprintf(stderr, "kernel_launch: hipFuncSetAttribute failed\n"); grid = -1; return; }
        if (hipOccupancyMaxActiveBlocksPerMultiprocessor(&per_cu, (const void*)fwd_kernel, NTHREADS, LDS_BYTES) != hipSuccess || per_cu < 1) fprintf(stderr, "kernel_launch: occupancy query says %d\n", per_cu);
        (void)hipGetLastError();
        grid = cus;
    }
    if (grid < 0) return;
    (void)hipMemsetAsync((char*)d_ws + WS_CTL, 0, CTL_ZERO_BYTES, stream);
    Args a{};
    for (int i = 0; i < N_IN; ++i) a.in[i] = (const float*)d_in[i];
    a.out = (float*)d_out; a.ws = (unsigned char*)d_ws;
#if ONE_LAUNCH
    a.ph_lo = 0; a.ph_hi = NPHASES;
    hipLaunchKernelGGL(fwd_kernel, dim3(grid), dim3(NTHREADS), LDS_BYTES, stream, a);
#else
    for (int ph = 0; ph < NPHASES; ++ph) {
        if (!phase_used(ph)) continue;
        a.ph_lo = ph; a.ph_hi = ph + 1;
        hipLaunchKernelGGL(fwd_kernel, dim3(grid), dim3(NTHREADS), LDS_BYTES, stream, a);
    }
#endif
}
```
